# Optimizing an MI355X kernel written in HIP

```python
import jax, jax.numpy as jnp
from jax import lax
import numpy as np

D_MODEL = 1024
BATCH = 8
SEQ = 4096
DEPTH = 4

HEAD_DIM = 64
ROPE_THETA = 10000.0
NORM_EPS = 1e-6
NEG_INF = -1e30
D_FF = 2816

DIL_HEADS = 8
DIL_CONFIGS = ((128, 1), (512, 4), (2048, 16))
NA_HEADS = 8
GRID_W = 64
NA_ROWS = 8
NA_COLS = 16
NA_QCOLS = 16
NA_KCOLS = 32

SWA_Q_HEADS = 8
SWA_KV_HEADS = 2
SWA_HALF = 128
SWA_BLOCK = 128
MLA_HEADS = 8
MLA_Q_RANK = 384
MLA_KV_RANK = 256
MLA_NOPE = 64
MLA_ROPE = 32
MLA_V = 64
MLA_Q_BLOCK = 128

EVEN_SPLITS = (DIL_HEADS * HEAD_DIM,) * 3 + (NA_HEADS * HEAD_DIM,) * 3
EVEN_IN = sum(EVEN_SPLITS)
EVEN_MIX = (DIL_HEADS + NA_HEADS) * HEAD_DIM
ODD_SPLITS = (SWA_Q_HEADS * HEAD_DIM, SWA_KV_HEADS * HEAD_DIM, SWA_KV_HEADS * HEAD_DIM,
              MLA_Q_RANK, MLA_KV_RANK, MLA_ROPE)
ODD_IN = sum(ODD_SPLITS)
ODD_MIX = SWA_Q_HEADS * HEAD_DIM + MLA_HEADS * MLA_V

kernel_name = 'hybrid_bidir_encoder'


def rms_norm(x, g):
    xf = x.astype(jnp.float32)
    y = xf * lax.rsqrt(jnp.mean(xf * xf, axis=-1, keepdims=True) + NORM_EPS)
    return (y * g.astype(jnp.float32)).astype(x.dtype)


def rope_tables(seq, dim):
    pos = jnp.arange(seq, dtype=jnp.float32)
    inv_freq = ROPE_THETA ** (-jnp.arange(0, dim, 2, dtype=jnp.float32) / dim)
    ang = pos[:, None] * inv_freq[None, :]
    return jnp.cos(ang), jnp.sin(ang)


def apply_rope(x, cos, sin):
    half = x.shape[-1] // 2
    bshape = (cos.shape[0],) + (1,) * (x.ndim - 3) + (half,)
    c, s = cos.reshape(bshape), sin.reshape(bshape)
    xf = x.astype(jnp.float32)
    x1, x2 = xf[..., :half], xf[..., half:]
    return jnp.concatenate([x1 * c - x2 * s, x2 * c + x1 * s], axis=-1).astype(x.dtype)


def swiglu(x, w1, w3, w2):
    return (jax.nn.silu(x @ w1) * (x @ w3)) @ w2


def banded_window_attn(q, k, v, half, block, sink=None):
    n, L, hk, g, dh = q.shape
    nb = -(-L // block)
    lp = nb * block
    scale = dh ** -0.5
    qb = jnp.pad(q, ((0, 0), (0, lp - L), (0, 0), (0, 0), (0, 0))).reshape(n, nb, block, hk, g, dh)
    pad_kv = ((0, 0), (block, lp - L + block), (0, 0), (0, 0))
    kp = jnp.pad(k, pad_kv).reshape(n, nb + 2, block, hk, dh)
    vp = jnp.pad(v, pad_kv).reshape(n, nb + 2, block, hk, dh)
    kb = jnp.concatenate([kp[:, :-2], kp[:, 1:-1], kp[:, 2:]], axis=2)
    vb = jnp.concatenate([vp[:, :-2], vp[:, 1:-1], vp[:, 2:]], axis=2)
    sc = jnp.einsum('nbqhgd,nbkhd->nbhgqk', qb, kb, preferred_element_type=jnp.float32) * scale
    qpos = np.arange(nb)[:, None] * block + np.arange(block)[None, :]
    kpos = (np.arange(nb)[:, None] - 1) * block + np.arange(3 * block)[None, :]
    valid = ((np.abs(qpos[:, :, None] - kpos[:, None, :]) <= half)
             & (kpos[:, None, :] >= 0) & (kpos[:, None, :] < L))
    sc = jnp.where(valid[None, :, None, None], sc, NEG_INF)
    m = jnp.max(sc, axis=-1)
    if sink is not None:
        sk = sink.astype(jnp.float32).reshape(1, 1, hk, g, 1)
        m = jnp.maximum(m, sk)
    p = jnp.exp(sc - m[..., None])
    denom = jnp.sum(p, axis=-1)
    if sink is not None:
        denom = denom + jnp.exp(sk - m)
    o = jnp.einsum('nbhgqk,nbkhd->nbqhgd', p, vb.astype(jnp.float32))
    o = o / jnp.moveaxis(denom, -1, 2)[..., None]
    lse = jnp.moveaxis(m + jnp.log(denom), -1, 2)
    o = o.reshape(n, lp, hk, g, dh)[:, :L].astype(q.dtype)
    lse = lse.reshape(n, lp, hk, g)[:, :L]
    return o, lse


def dilated_attention(q, k, v):
    b, s, h, dh = q.shape
    outs, lses = [], []
    for window, dil in DIL_CONFIGS:
        half = window // 2 // dil
        sd = s // dil

        def to_res(t):
            return t.reshape(b, sd, dil, h, dh).transpose(0, 2, 1, 3, 4).reshape(b * dil, sd, h, dh)

        o, lse = banded_window_attn(to_res(q)[:, :, :, None], to_res(k), to_res(v), half, half)
        outs.append(o[:, :, :, 0].reshape(b, dil, sd, h, dh).transpose(0, 2, 1, 3, 4).reshape(b, s, h, dh))
        lses.append(lse[..., 0].reshape(b, dil, sd, h).transpose(0, 2, 1, 3).reshape(b, s, h))
    w = jax.nn.softmax(jnp.stack(lses), axis=0)
    out = jnp.einsum('cbsh,cbshd->bshd', w, jnp.stack(outs).astype(jnp.float32))
    return out.astype(q.dtype)


def neighbourhood_attention(q, k, v, rpb):
    b, s, h, dh = q.shape
    rows = s // GRID_W
    kr = min(NA_ROWS, rows)
    ncb = GRID_W // NA_QCOLS
    scale = dh ** -0.5
    qg = q.reshape(b, rows, GRID_W, h, dh)
    kg = k.reshape(b, rows, GRID_W, h, dh)
    vg = v.reshape(b, rows, GRID_W, h, dh)
    qcol = np.arange(GRID_W).reshape(ncb, NA_QCOLS)
    kstart = np.clip(np.arange(ncb) * NA_QCOLS - NA_COLS // 2, 0, GRID_W - NA_KCOLS)
    kcol = kstart[:, None] + np.arange(NA_KCOLS)[None, :]
    wstart = np.clip(qcol - NA_COLS // 2, 0, GRID_W - NA_COLS)
    col_valid = ((kcol[:, None, :] >= wstart[..., None])
                 & (kcol[:, None, :] < wstart[..., None] + NA_COLS))
    dc_idx = np.clip(kcol[:, None, :] - qcol[..., None] + NA_COLS - 1, 0, 2 * NA_COLS - 2)
    rpb_c = rpb[:, :, dc_idx]

    def row_step(r):
        rs = jnp.clip(r - kr // 2, 0, rows - kr)
        k_rows = lax.dynamic_slice_in_dim(kg, rs, kr, axis=1)[:, :, kcol]
        v_rows = lax.dynamic_slice_in_dim(vg, rs, kr, axis=1)[:, :, kcol]
        q_row = lax.dynamic_index_in_dim(qg, r, axis=1, keepdims=False).reshape(b, ncb, NA_QCOLS, h, dh)
        sc = jnp.einsum('bmqhd,brmkhd->bhmqrk', q_row, k_rows, preferred_element_type=jnp.float32) * scale
        dr_idx = rs - r + jnp.arange(kr) + NA_ROWS - 1
        bias = jnp.take(rpb_c, dr_idx, axis=1).transpose(0, 2, 3, 1, 4)
        sc = sc + bias[None].astype(jnp.float32)
        sc = jnp.where(col_valid[None, None, :, :, None, :], sc, NEG_INF)
        p = jax.nn.softmax(sc, axis=(-2, -1))
        o = jnp.einsum('bhmqrk,brmkhd->bmqhd', p, v_rows.astype(jnp.float32))
        return o.reshape(b, GRID_W, h, dh).astype(q.dtype)

    out = lax.map(row_step, jnp.arange(rows))
    return out.transpose(1, 0, 2, 3, 4).reshape(b, s, h, dh)


def mla_attention(q_a, kv_a, k_pe, q_norm, w_qb, kv_norm, w_kvb, cos_r, sin_r):
    b, s, _ = q_a.shape
    q = (rms_norm(q_a, q_norm) @ w_qb).reshape(b, s, MLA_HEADS, MLA_NOPE + MLA_ROPE)
    q_nope = q[..., :MLA_NOPE]
    q_pe = apply_rope(q[..., MLA_NOPE:], cos_r, sin_r)
    kv = (rms_norm(kv_a, kv_norm) @ w_kvb).reshape(b, s, MLA_HEADS, MLA_NOPE + MLA_V)
    k_nope = kv[..., :MLA_NOPE]
    v_f = kv[..., MLA_NOPE:].astype(jnp.float32)
    k_pe = apply_rope(k_pe, cos_r, sin_r)
    scale = (MLA_NOPE + MLA_ROPE) ** -0.5
    nqb = s // MLA_Q_BLOCK

    def blocks(t):
        return t.reshape((b, nqb, MLA_Q_BLOCK) + t.shape[2:]).swapaxes(0, 1)

    def step(args):
        qn, qp = args
        sc = (jnp.einsum('bqhd,bkhd->bhqk', qn, k_nope, preferred_element_type=jnp.float32)
              + jnp.einsum('bqhr,bkr->bhqk', qp, k_pe, preferred_element_type=jnp.float32)) * scale
        p = jax.nn.softmax(sc, axis=-1)
        return jnp.einsum('bhqk,bkhd->bqhd', p, v_f)

    o = lax.map(step, (blocks(q_nope), blocks(q_pe)))
    return o.swapaxes(0, 1).reshape(b, s, MLA_HEADS * MLA_V).astype(q_a.dtype)


def even_mixer(h, w_in, w_out, rpb, cos, sin):
    b, s, _ = h.shape
    proj = h @ w_in
    qa, ka, va, qn, kn, vn = jnp.split(proj, np.cumsum(EVEN_SPLITS[:-1]).tolist(), axis=-1)
    qa = apply_rope(qa.reshape(b, s, DIL_HEADS, HEAD_DIM), cos, sin)
    ka = apply_rope(ka.reshape(b, s, DIL_HEADS, HEAD_DIM), cos, sin)
    oa = dilated_attention(qa, ka, va.reshape(b, s, DIL_HEADS, HEAD_DIM))
    on = neighbourhood_attention(qn.reshape(b, s, NA_HEADS, HEAD_DIM), kn.reshape(b, s, NA_HEADS, HEAD_DIM),
                                 vn.reshape(b, s, NA_HEADS, HEAD_DIM), rpb)
    mixed = jnp.concatenate([oa.reshape(b, s, DIL_HEADS * HEAD_DIM), on.reshape(b, s, NA_HEADS * HEAD_DIM)], axis=-1)
    return mixed @ w_out


def odd_mixer(h, w_in, w_out, sink, q_norm, w_qb, kv_norm, w_kvb, cos, sin, cos_r, sin_r):
    b, s, _ = h.shape
    proj = h @ w_in
    q_c, k_c, v_c, q_a, kv_a, k_pe = jnp.split(proj, np.cumsum(ODD_SPLITS[:-1]).tolist(), axis=-1)
    grp = SWA_Q_HEADS // SWA_KV_HEADS
    qc = apply_rope(q_c.reshape(b, s, SWA_Q_HEADS, HEAD_DIM), cos, sin).reshape(b, s, SWA_KV_HEADS, grp, HEAD_DIM)
    kc = apply_rope(k_c.reshape(b, s, SWA_KV_HEADS, HEAD_DIM), cos, sin)
    vc = v_c.reshape(b, s, SWA_KV_HEADS, HEAD_DIM)
    oc, _ = banded_window_attn(qc, kc, vc, SWA_HALF, SWA_BLOCK, sink.reshape(SWA_KV_HEADS, grp))
    od = mla_attention(q_a, kv_a, k_pe, q_norm, w_qb, kv_norm, w_kvb, cos_r, sin_r)
    mixed = jnp.concatenate([oc.reshape(b, s, SWA_Q_HEADS * HEAD_DIM), od], axis=-1)
    return mixed @ w_out


def setup_inputs(seed: int = 0) -> dict:
    key = jax.random.key(seed)
    ks = jax.random.split(key, 21)
    n_even, n_odd = (DEPTH + 1) // 2, DEPTH // 2

    def dense(k, shape, fan_in):
        return jax.random.normal(k, shape, jnp.float32) * fan_in ** -0.5

    def gain(k, shape):
        return 1.0 + 0.02 * jax.random.normal(k, shape, jnp.float32)

    return {
        'x': jax.random.normal(ks[0], (BATCH, SEQ, D_MODEL), jnp.float32),
        'ffn1_norm': gain(ks[1], (DEPTH, D_MODEL)),
        'ffn1_w1': dense(ks[2], (DEPTH, D_MODEL, D_FF), D_MODEL),
        'ffn1_w3': dense(ks[3], (DEPTH, D_MODEL, D_FF), D_MODEL),
        'ffn1_w2': dense(ks[4], (DEPTH, D_FF, D_MODEL), D_FF),
        'mix_norm': gain(ks[5], (DEPTH, D_MODEL)),
        'ffn2_norm': gain(ks[6], (DEPTH, D_MODEL)),
        'ffn2_w1': dense(ks[7], (DEPTH, D_MODEL, D_FF), D_MODEL),
        'ffn2_w3': dense(ks[8], (DEPTH, D_MODEL, D_FF), D_MODEL),
        'ffn2_w2': dense(ks[9], (DEPTH, D_FF, D_MODEL), D_FF),
        'even_w_in': dense(ks[10], (n_even, D_MODEL, EVEN_IN), D_MODEL),
        'even_w_out': dense(ks[11], (n_even, EVEN_MIX, D_MODEL), EVEN_MIX),
        'na_rel_bias': 0.1 * jax.random.normal(ks[12], (n_even, NA_HEADS, 2 * NA_ROWS - 1, 2 * NA_COLS - 1), jnp.float32),
        'odd_w_in': dense(ks[13], (n_odd, D_MODEL, ODD_IN), D_MODEL),
        'odd_w_out': dense(ks[14], (n_odd, ODD_MIX, D_MODEL), ODD_MIX),
        'swa_sink': jax.random.normal(ks[15], (n_odd, SWA_Q_HEADS), jnp.float32),
        'mla_q_norm': gain(ks[16], (n_odd, MLA_Q_RANK)),
        'mla_w_qb': dense(ks[17], (n_odd, MLA_Q_RANK, MLA_HEADS * (MLA_NOPE + MLA_ROPE)), MLA_Q_RANK),
        'mla_kv_norm': gain(ks[18], (n_odd, MLA_KV_RANK)),
        'mla_w_kvb': dense(ks[19], (n_odd, MLA_KV_RANK, MLA_HEADS * (MLA_NOPE + MLA_V)), MLA_KV_RANK),
        'final_norm': gain(ks[20], (D_MODEL,)),
    }


def reference(x, ffn1_norm, ffn1_w1, ffn1_w3, ffn1_w2, mix_norm, ffn2_norm, ffn2_w1, ffn2_w3, ffn2_w2,
              even_w_in, even_w_out, na_rel_bias, odd_w_in, odd_w_out, swa_sink,
              mla_q_norm, mla_w_qb, mla_kv_norm, mla_w_kvb, final_norm):
    s = x.shape[1]
    cos, sin = rope_tables(s, HEAD_DIM)
    cos_r, sin_r = rope_tables(s, MLA_ROPE)
    h = x
    for i in range(DEPTH):
        j = i // 2
        h = h + 0.5 * swiglu(rms_norm(h, ffn1_norm[i]), ffn1_w1[i], ffn1_w3[i], ffn1_w2[i])
        hn = rms_norm(h, mix_norm[i])
        if i % 2 == 0:
            h = h + even_mixer(hn, even_w_in[j], even_w_out[j], na_rel_bias[j], cos, sin)
        else:
            h = h + odd_mixer(hn, odd_w_in[j], odd_w_out[j], swa_sink[j], mla_q_norm[j], mla_w_qb[j],
                              mla_kv_norm[j], mla_w_kvb[j], cos, sin, cos_r, sin_r)
        h = h + 0.5 * swiglu(rms_norm(h, ffn2_norm[i]), ffn2_w1[i], ffn2_w3[i], ffn2_w2[i])
    return rms_norm(h, final_norm)
```

```cpp
#include <hip/hip_runtime.h>
#include <hip/hip_cooperative_groups.h>
#include <cstdio>
#include <cstdint>
#include <cmath>
namespace cg = cooperative_groups;
#ifndef EN_DIL
#define EN_DIL 1
#endif
#ifndef EN_NA
#define EN_NA 1
#endif
#ifndef EN_MLA
#define EN_MLA 1
#endif
#ifndef EN_SWA
#define EN_SWA 1
#endif
#ifndef EN_GEMM
#define EN_GEMM 1
#endif
#ifndef EN_MISC
#define EN_MISC 1
#endif

#define LAS __attribute__((address_space(3)))
typedef unsigned short bf16_t;
typedef short bf16x8 __attribute__((ext_vector_type(8)));
typedef short s16x4 __attribute__((ext_vector_type(4)));
typedef float f32x4 __attribute__((ext_vector_type(4)));
typedef float f32x16 __attribute__((ext_vector_type(16)));
typedef unsigned u32x4 __attribute__((ext_vector_type(4)));
typedef unsigned u32x2 __attribute__((ext_vector_type(2)));

constexpr int T = 32768, DM = 1024, FF = 2816, SEQ = 4096, DEPTH = 4;
constexpr int EVEN_IN = 3072, ODD_IN = 1440, ODD_INP = 1536;
constexpr float NORM_EPS = 1e-6f;
constexpr float LOG2E = 1.4426950408889634f, LN2 = 0.6931471805599453f;
constexpr int NTHREADS = 512, NWAVES = 8;
constexpr int LDS_BYTES = 163840;

constexpr size_t MiB = 1u << 20;
constexpr size_t WS_COS = 0, WS_SIN = 512 * 1024;
constexpr size_t WS_W = 1 * MiB;
constexpr size_t W_UP1 = WS_W, W_DN1 = W_UP1 + (size_t)2 * FF * DM * 2, W_UP2 = W_DN1 + (size_t)DM * FF * 2, W_DN2 = W_UP2 + (size_t)2 * FF * DM * 2,
                 W_IN = W_DN2 + (size_t)DM * FF * 2, W_OUT = W_IN + (size_t)EVEN_IN * DM * 2, W_QB = W_OUT + (size_t)DM * DM * 2, W_KVB = W_QB + (size_t)768 * 384 * 2,
                 W_END = W_KVB + (size_t)1024 * 256 * 2;
static_assert(W_END <= 49 * MiB, "weights region");
constexpr size_t WS_HN = 49 * MiB;
constexpr size_t WS_BIG = WS_HN + 64 * MiB;
constexpr size_t WS_AUX = WS_BIG + 192 * MiB;
constexpr size_t AUX_LSE = 96 * MiB, AUX_KV = 48 * MiB;
constexpr size_t WS_NAO = WS_AUX + 116 * MiB;
constexpr size_t WS_BAR = WS_NAO + 64 * MiB;
constexpr size_t WS_END = WS_BAR + 16384;

__device__ __forceinline__ unsigned cvt_pk_bf16(float lo, float hi) { unsigned r; asm volatile("v_cvt_pk_bf16_f32 %0, %1, %2" : "=v"(r) : "v"(lo), "v"(hi)); return r; }
__device__ __forceinline__ float bf_lo(unsigned w) { return __uint_as_float(w << 16); }
__device__ __forceinline__ float bf_hi(unsigned w) { return __uint_as_float(w & 0xffff0000u); }
typedef _Float16 h16x2 __attribute__((ext_vector_type(2)));
__device__ __forceinline__ unsigned pk_f16(float lo, float hi) { const h16x2 v = (h16x2){(_Float16)lo, (_Float16)hi}; return __builtin_bit_cast(unsigned, v); }
__device__ __forceinline__ float f16_lo(unsigned w) { return (float)__builtin_bit_cast(h16x2, w)[0]; }
__device__ __forceinline__ float f16_hi(unsigned w) { return (float)__builtin_bit_cast(h16x2, w)[1]; }
template <int MASK> __device__ __forceinline__ float swz_xor(float v) { return __int_as_float(__builtin_amdgcn_ds_swizzle(__float_as_int(v), (MASK << 10) | 0x1f)); }
__device__ __forceinline__ float half_sum(float v) { auto rr = __builtin_amdgcn_permlane32_swap(__float_as_uint(v), __float_as_uint(v), false, false); return __uint_as_float(rr[0]) + __uint_as_float(rr[1]); }
__device__ __forceinline__ float half_max(float v) { auto rr = __builtin_amdgcn_permlane32_swap(__float_as_uint(v), __float_as_uint(v), false, false); return fmaxf(__uint_as_float(rr[0]), __uint_as_float(rr[1])); }
__device__ __forceinline__ float wave_sum(float v) {
    v += swz_xor<1>(v); v += swz_xor<2>(v); v += swz_xor<4>(v); v += swz_xor<8>(v); v += swz_xor<16>(v);
    return half_sum(v);
}
__device__ __forceinline__ float max3f(float a, float b, float c) { float r; asm("v_max3_f32 %0, %1, %2, %3" : "=v"(r) : "v"(a), "v"(b), "v"(c)); return r; }
__device__ __forceinline__ int crow(int r, int hi) { return (r & 3) + 8 * (r >> 2) + 4 * hi; }
__device__ __forceinline__ int clampi(int v, int lo, int hi) { return v < lo ? lo : (v > hi ? hi : v); }

namespace pg8 {
constexpr int BM = 256, BK = 64, HALF = 128, HTB = HALF * BK * 2  , STAGE_BYTES = 8 * HTB, NXCD = 8, WGM = 8;

__host__ __device__ __forceinline__ int lds_byte(int r, int c) { const int st = (r >> 4) * 2 + (c >> 5), rr = r & 15, cc = c & 31, ob = rr * 64 + cc * 2; return st * 1024 + (ob ^ (((ob >> 9) & 1) << 5)); }
__host__ __device__ __forceinline__ void stage_rc(int b, int& R, int& C) { const int st = b / 1024, sb = b % 1024, swz = sb ^ (((sb >> 9) & 1) << 5); R = (st >> 1) * 16 + swz / 64; C = (st & 1) * 32 + (swz % 64) / 2; }
__host__ __device__ __forceinline__ int perm32(int rho) { const int n = rho >> 4, i = rho & 15; return 8 * (i >> 2) + 4 * n + (i & 3); }

struct Unit { int pm, pn; };
struct Gemm { const bf16_t* A; const bf16_t* Bt; int M, N, K, lda; };

struct StaticOrder {
    int nM, nN, nwg, G, c;
    __host__ __device__ void init(int M, int N, int G_, int c_) { nM = M / BM; nN = N / BM; nwg = nM * nN; G = G_; c = c_; }
    __host__ __device__ bool next(int i, Unit& u) const {
        const long L = (long)i * G + c; if (L >= nwg) return false;
        int wgid = (int)L; { const int q = nwg / NXCD, r = nwg % NXCD, xcd = wgid % NXCD, off = wgid / NXCD; wgid = (xcd < r ? xcd * (q + 1) : r * (q + 1) + (xcd - r) * q) + off; }
        const int nig = WGM * nN, gid = wgid / nig, fm = gid * WGM, gsz = (nM - fm) < WGM ? (nM - fm) : WGM;
        u.pm = fm + ((wgid % nig) % gsz); u.pn = (wgid % nig) / gsz; return true;
    }
};


struct EpiBf16 {
    static constexpr bool PERM = true;
    bf16_t* O; int ldc;
    __device__ __forceinline__ void operator()(const f32x4 (&acc)[2][2][4][2], const Unit& u, int wr, int wc, int fr, int fq) const {
        const int row0 = u.pm * BM + wr * 64 + fr; const int col0 = u.pn * BM + wc * 32 + 8 * fq;
#pragma unroll
        for (int ai = 0; ai < 2; ++ai)
#pragma unroll
            for (int m = 0; m < 4; ++m) { bf16_t* rowp = O + (size_t)(row0 + ai * HALF + m * 16) * ldc + col0;
#pragma unroll
                for (int bj = 0; bj < 2; ++bj) { const f32x4 v0 = acc[ai][bj][m][0], v1 = acc[ai][bj][m][1];
                    u32x4 w; w.x = cvt_pk_bf16(v0[0], v0[1]); w.y = cvt_pk_bf16(v0[2], v0[3]); w.z = cvt_pk_bf16(v1[0], v1[1]); w.w = cvt_pk_bf16(v1[2], v1[3]);
                    *(u32x4*)(rowp + bj * HALF) = w; } }
    }
};
struct EpiSwiglu {
    static constexpr bool PERM = true;
    bf16_t* O; int ldc;
    __device__ __forceinline__ float sg(float a, float b) const { const float e = __builtin_amdgcn_exp2f(-a * LOG2E); return a * b * __builtin_amdgcn_rcpf(1.0f + e); }
    __device__ __forceinline__ void operator()(const f32x4 (&acc)[2][2][4][2], const Unit& u, int wr, int wc, int fr, int fq) const {
        const int row0 = u.pm * BM + wr * 64 + fr; const int col0 = u.pn * HALF + wc * 32 + 8 * fq;
#pragma unroll
        for (int ai = 0; ai < 2; ++ai)
#pragma unroll
            for (int m = 0; m < 4; ++m) { bf16_t* rowp = O + (size_t)(row0 + ai * HALF + m * 16) * ldc + col0;
                const f32x4 a0 = acc[ai][0][m][0], a1 = acc[ai][0][m][1], b0 = acc[ai][1][m][0], b1 = acc[ai][1][m][1];
                u32x4 w; w.x = cvt_pk_bf16(sg(a0[0], b0[0]), sg(a0[1], b0[1])); w.y = cvt_pk_bf16(sg(a0[2], b0[2]), sg(a0[3], b0[3]));
                w.z = cvt_pk_bf16(sg(a1[0], b1[0]), sg(a1[1], b1[1])); w.w = cvt_pk_bf16(sg(a1[2], b1[2]), sg(a1[3], b1[3]));
                *(u32x4*)rowp = w; }
    }
};
struct EpiResid {
    static constexpr bool PERM = false;
    const float* basef; bf16_t* h; int ldc; float scale;
    __device__ __forceinline__ void operator()(const f32x4 (&acc)[2][2][4][2], const Unit& u, int wr, int wc, int fr, int fq) const {
        const int col0 = u.pn * BM + wc * 32 + 4 * fq;
#pragma unroll
        for (int ai = 0; ai < 2; ++ai)
#pragma unroll
            for (int m = 0; m < 4; ++m) { const size_t off = (size_t)(u.pm * BM + ai * HALF + wr * 64 + m * 16 + fr) * ldc + col0;
#pragma unroll
                for (int bj = 0; bj < 2; ++bj)
#pragma unroll
                    for (int n = 0; n < 2; ++n) { f32x4 bs;
                        if (basef) bs = *(const f32x4*)(basef + off + bj * HALF + n * 16);
                        else { const u32x2 w = *(const u32x2*)(h + off + bj * HALF + n * 16); bs = (f32x4){f16_lo(w.x), f16_hi(w.x), f16_lo(w.y), f16_hi(w.y)}; }
                        const f32x4 o = bs + acc[ai][bj][m][n] * scale;
                        u32x2 wo; wo.x = pk_f16(o[0], o[1]); wo.y = pk_f16(o[2], o[3]); *(u32x2*)(h + off + bj * HALF + n * 16) = wo; }
                asm volatile("" ::: "memory"); }
    }
};

template <class Epi, class Sched>
__device__ __forceinline__ void gemm_phase(LAS unsigned char* lds, const Gemm g, const Sched& S, const Epi& E, const int tid) {
    const int wid = __builtin_amdgcn_readfirstlane(tid >> 6), lane = tid & 63, wr = wid >> 2, wc = wid & 3, fr = lane & 15, fq = lane >> 4;
    const int K = g.K, nt = K / BK, lda = g.lda;
    unsigned voffA[2], voffB[2];
#pragma unroll
    for (int i = 0; i < 2; ++i) { int R, C; stage_rc(tid * 16 + i * 8192, R, C); const int Rb = Epi::PERM ? ((R & ~31) + perm32(R & 31)) : R;
        voffA[i] = (unsigned)(R * lda + C) * 2u; voffB[i] = (unsigned)(Rb * K + C) * 2u; }
    const size_t kstep = (size_t)(BK * 2);
    const size_t hstepA = (size_t)HALF * lda * 2, hstepB = (size_t)HALF * K * 2;
    const size_t tstepA = 2 * hstepA, tstepB = 2 * hstepB;
    const unsigned ldsw = (unsigned)wid * 1024u;
    const int aoff = lds_byte(wr * 64 + fr, fq * 8), boff = lds_byte(wc * 32 + fr, fq * 8);
#define PG8_SA(b, h) (((b) * 2 + (h)) * HTB)
#define PG8_SB(b, h) ((4 + (b) * 2 + (h)) * HTB)
#define PG8_STAGE(bufoff, gbase, voff) do { _Pragma("unroll") for (int _i = 0; _i < 2; ++_i) \
        __builtin_amdgcn_global_load_lds((const unsigned*)((const char*)(gbase) + (voff)[_i]), (LAS unsigned*)(lds + (bufoff) + ldsw + _i * 8192), 16, 0, 0); } while (0)
#define PG8_LDA(dst, b, h) do { _Pragma("unroll") for (int m = 0; m < 4; ++m) _Pragma("unroll") for (int k = 0; k < 2; ++k) dst[m][k] = *(const LAS bf16x8*)(lds + PG8_SA(b, h) + aoff + m * 2048 + k * 1024); } while (0)
#define PG8_LDB(dst, b, h) do { _Pragma("unroll") for (int n = 0; n < 2; ++n) _Pragma("unroll") for (int k = 0; k < 2; ++k) dst[n][k] = *(const LAS bf16x8*)(lds + PG8_SB(b, h) + boff + n * 2048 + k * 1024); } while (0)
#define PG8_MMA(ai, bj, At, Bt) do { __builtin_amdgcn_s_setprio(1); _Pragma("unroll") for (int m = 0; m < 4; ++m) _Pragma("unroll") for (int n = 0; n < 2; ++n) _Pragma("unroll") for (int k = 0; k < 2; ++k) \
        acc[ai][bj][m][n] = __builtin_amdgcn_mfma_f32_16x16x32_bf16(Bt[n][k], At[m][k], acc[ai][bj][m][n], 0, 0, 0); __builtin_amdgcn_s_setprio(0); } while (0)
#define PG8_WAIT_V(n) asm volatile("s_waitcnt vmcnt(" #n ")" ::: "memory")
#define PG8_WAIT_L(n) asm volatile("s_waitcnt lgkmcnt(" #n ")" ::: "memory")
#define PG8_BAR __builtin_amdgcn_s_barrier()
#define PG8_SCHED __builtin_amdgcn_sched_barrier(0)
    Unit cur, nxt; int ui = 0;
    if (!S.next(0, cur)) return;
    f32x4 acc[2][2][4][2];
#pragma unroll
    for (int a = 0; a < 2; ++a)
#pragma unroll
        for (int b = 0; b < 2; ++b)
#pragma unroll
            for (int m = 0; m < 4; ++m)
#pragma unroll
                for (int n = 0; n < 2; ++n) acc[a][b][m][n] = (f32x4){0.f, 0.f, 0.f, 0.f};
    bf16x8 At[4][2], B0[2][2], B1[2][2];
    const char* cA = (const char*)g.A + (size_t)cur.pm * tstepA; const char* cB = (const char*)g.Bt + (size_t)cur.pn * tstepB;
    PG8_STAGE(PG8_SB(0, 0), cB, voffB); PG8_STAGE(PG8_SB(0, 1), cB + hstepB, voffB); PG8_STAGE(PG8_SA(0, 0), cA, voffA); PG8_STAGE(PG8_SA(0, 1), cA + hstepA, voffA);
    if (wr == 1) PG8_BAR;
    PG8_WAIT_V(2); PG8_BAR;
    PG8_STAGE(PG8_SB(1, 0), cB + kstep, voffB); PG8_STAGE(PG8_SA(1, 0), cA + kstep, voffA); PG8_STAGE(PG8_SB(1, 1), cB + hstepB + kstep, voffB);
    PG8_WAIT_V(6); PG8_BAR;
    for (;;) {
        const bool has_next = S.next(ui + 1, nxt);
        const char* nA = has_next ? (const char*)g.A + (size_t)nxt.pm * tstepA : cA; const char* nB = has_next ? (const char*)g.Bt + (size_t)nxt.pn * tstepB : cB;
        for (int t = 0; t < nt; t += 2) {
            const bool last = (t == nt - 2);
            const char* a1 = cA + (size_t)(t + 1) * kstep;
            const char* a2 = last ? nA : cA + (size_t)(t + 2) * kstep; const char* b2 = last ? nB : cB + (size_t)(t + 2) * kstep;
            const char* a3 = a2 + kstep; const char* b3 = b2 + kstep;
            PG8_LDB(B0, 0, 0); PG8_LDB(B1, 0, 1); PG8_SCHED; PG8_LDA(At, 0, 0); PG8_STAGE(PG8_SA(1, 1), a1 + hstepA, voffA);
            PG8_WAIT_V(8); PG8_WAIT_L(0); PG8_BAR; PG8_MMA(0, 0, At, B0); PG8_MMA(0, 1, At, B1); PG8_BAR; PG8_SCHED;
            PG8_LDA(At, 0, 1); PG8_STAGE(PG8_SB(0, 0), b2, voffB); PG8_STAGE(PG8_SB(0, 1), b2 + hstepB, voffB); PG8_STAGE(PG8_SA(0, 0), a2, voffA);
            PG8_WAIT_V(8); PG8_WAIT_L(0); PG8_BAR; PG8_MMA(1, 0, At, B0); PG8_MMA(1, 1, At, B1); PG8_BAR; PG8_SCHED;
            PG8_LDB(B0, 1, 0); PG8_LDB(B1, 1, 1); PG8_SCHED; PG8_LDA(At, 1, 0); PG8_STAGE(PG8_SA(0, 1), a2 + hstepA, voffA);
            PG8_WAIT_V(8); PG8_WAIT_L(0); PG8_BAR; PG8_MMA(0, 0, At, B0); PG8_MMA(0, 1, At, B1); PG8_BAR; PG8_SCHED;
            PG8_LDA(At, 1, 1); PG8_STAGE(PG8_SB(1, 0), b3, voffB); PG8_STAGE(PG8_SB(1, 1), b3 + hstepB, voffB); PG8_STAGE(PG8_SA(1, 0), a3, voffA);
            PG8_WAIT_V(8); PG8_WAIT_L(0); PG8_BAR; PG8_MMA(1, 0, At, B0); PG8_MMA(1, 1, At, B1); PG8_BAR; PG8_SCHED;
        }
        if (wr == 0) PG8_BAR;
        { int l2 = lane; asm volatile("" : "+v"(l2)); E(acc, cur, wr, wc, l2 & 15, l2 >> 4); }
        if (!has_next) break;
#pragma unroll
        for (int a = 0; a < 2; ++a)
#pragma unroll
            for (int b = 0; b < 2; ++b)
#pragma unroll
                for (int m = 0; m < 4; ++m)
#pragma unroll
                    for (int n = 0; n < 2; ++n) acc[a][b][m][n] = (f32x4){0.f, 0.f, 0.f, 0.f};
        cur = nxt; cA = nA; cB = nB; ++ui;
        if (wr == 1) PG8_BAR;
    }
    PG8_WAIT_V(0);
    PG8_BAR;
#undef PG8_SA
#undef PG8_SB
#undef PG8_STAGE
#undef PG8_LDA
#undef PG8_LDB
#undef PG8_MMA
#undef PG8_WAIT_V
#undef PG8_WAIT_L
#undef PG8_BAR
#undef PG8_SCHED
}
}

#define MFMA32(a, b, c) __builtin_amdgcn_mfma_f32_32x32x16_bf16(a, b, c, 0, 0, 0)
typedef short v4i16_t __attribute__((ext_vector_type(4)));
__device__ __forceinline__ s16x4 vtr(const LAS unsigned char* p) { return __builtin_bit_cast(s16x4, __builtin_amdgcn_ds_read_tr16_b64_v4i16((LAS v4i16_t*)p)); }

template <int ND, class Spec>
__device__ __forceinline__ void attn_scores(const bf16x8 (&q)[ND], const LAS unsigned char* kb, const int kstride,
                                            f32x16 (&o)[2], float& m, float& l, const Spec& sp, const int t, LAS float* wsf, const int lane, u32x4 (&pw)[4]) {
    const int r32 = lane & 31, hi = lane >> 5;
    f32x16 p0, p1;
    const f32x16 z16 = (f32x16){0.f, 0.f, 0.f, 0.f, 0.f, 0.f, 0.f, 0.f, 0.f, 0.f, 0.f, 0.f, 0.f, 0.f, 0.f, 0.f};
    const LAS unsigned char* kp = kb + r32 * kstride + hi * 16;
#pragma unroll
    for (int d0 = 0; d0 < ND; ++d0) {
        const bf16x8 k0 = *(const LAS bf16x8*)(kp + d0 * 32);
        const bf16x8 k1 = *(const LAS bf16x8*)(kp + 32 * kstride + d0 * 32);
        if (d0 == 0) { p0 = MFMA32(k0, q[d0], z16); p1 = MFMA32(k1, q[d0], z16); }
        else { p0 = MFMA32(k0, q[d0], p0); p1 = MFMA32(k1, q[d0], p1); }
    }
    { const auto cx = sp.prep(t, r32, hi);
#pragma unroll
      for (int r = 0; r < 16; ++r) { p0[r] = sp.mask(p0[r], cx, r, 0); p1[r] = sp.mask(p1[r], cx, r, 1); } }
    float rm = max3f(p0[0], p0[1], p1[0]), rb = max3f(p0[2], p0[3], p1[1]); rm = max3f(rm, p1[2], p1[3]);
#pragma unroll
    for (int r = 4; r < 16; r += 4) { rm = max3f(rm, p0[r], p0[r + 1]); rb = max3f(rb, p0[r + 2], p0[r + 3]); rm = max3f(rm, p1[r], p1[r + 1]); rb = max3f(rb, p1[r + 2], p1[r + 3]); }
    rm = half_max(fmaxf(rm, rb)) * Spec::SC;
    const float mnew = fmaxf(m, rm);
    if (__any(mnew > m)) {
        const float mref = (mnew == -INFINITY) ? 0.f : mnew;
        const float alpha = __builtin_amdgcn_exp2f(m - mref);
        l *= alpha; m = mnew;
        if (hi == 0) wsf[r32] = alpha;
#pragma unroll
        for (int r = 0; r < 16; ++r) { const float a = wsf[crow(r, hi)]; o[0][r] *= a; o[1][r] *= a; }
    }
    const float mref = (m == -INFINITY) ? 0.f : m;
    float ls = 0.f;
#pragma unroll
    for (int r = 0; r < 16; ++r) { p0[r] = __builtin_amdgcn_exp2f(__builtin_fmaf(p0[r], Spec::SC, -mref)); p1[r] = __builtin_amdgcn_exp2f(__builtin_fmaf(p1[r], Spec::SC, -mref)); ls += p0[r] + p1[r]; }
    l += ls;
#pragma unroll
    for (int j = 0; j < 4; ++j) { pw[0][j] = cvt_pk_bf16(p0[2 * j], p0[2 * j + 1]); pw[1][j] = cvt_pk_bf16(p0[8 + 2 * j], p0[8 + 2 * j + 1]);
                                  pw[2][j] = cvt_pk_bf16(p1[2 * j], p1[2 * j + 1]); pw[3][j] = cvt_pk_bf16(p1[8 + 2 * j], p1[8 + 2 * j + 1]); }
}
__device__ __forceinline__ void attn_pv(const u32x4 (&pw)[4], const LAS unsigned char* vb, f32x16 (&o)[2], const int lane, const int vhs = 4096) {
    const int hi = lane >> 5;
    const LAS unsigned char* vp = vb + ((lane >> 4) & 1) * 32 + (lane & 3) * 8 + (4 * hi + ((lane & 15) >> 2)) * 64;
    s16x4 lo[2][4], hh[2][4];
#pragma unroll
    for (int ks = 0; ks < 4; ++ks)
#pragma unroll
        for (int d0 = 0; d0 < 2; ++d0) { lo[d0][ks] = vtr(vp + d0 * vhs + ks * 1024); hh[d0][ks] = vtr(vp + d0 * vhs + ks * 1024 + 512); }
#pragma unroll
    for (int ks = 0; ks < 4; ++ks)
#pragma unroll
        for (int d0 = 0; d0 < 2; ++d0) {
            const bf16x8 vf = (bf16x8){lo[d0][ks][0], lo[d0][ks][1], lo[d0][ks][2], lo[d0][ks][3], hh[d0][ks][0], hh[d0][ks][1], hh[d0][ks][2], hh[d0][ks][3]};
            o[d0] = MFMA32(__builtin_bit_cast(bf16x8, pw[ks]), vf, o[d0]);
        }
}

#define PIN16(x) asm volatile("" : "+v"(x))
template <int ND, bool HAS_NEXT>
__device__ __forceinline__ void dense_step(const bf16x8 (&q)[ND], const LAS unsigned char* kbn, const int kstride, const LAS unsigned char* vb,
                                           f32x16& PA0, f32x16& PA1, f32x16& PB0, f32x16& PB1, f32x16 (&o)[2], float& m, f32x16& lacc, const bf16x8 ones, const float SC, LAS float* wsf, const int lane) {
    const int r32 = lane & 31, hi = lane >> 5;
    float rm = max3f(PA0[0], PA0[1], PA1[0]), rb = max3f(PA0[2], PA0[3], PA1[1]); rm = max3f(rm, PA1[2], PA1[3]);
#pragma unroll
    for (int r = 4; r < 16; r += 4) { rm = max3f(rm, PA0[r], PA0[r + 1]); rb = max3f(rb, PA0[r + 2], PA0[r + 3]); rm = max3f(rm, PA1[r], PA1[r + 1]); rb = max3f(rb, PA1[r + 2], PA1[r + 3]); }
    rm = half_max(fmaxf(rm, rb)) * SC;
    const float mnew = fmaxf(m, rm);
    if (__any(mnew > m)) {
        const float alpha = __builtin_amdgcn_exp2f(m - mnew);
        m = mnew;
        if (hi == 0) wsf[r32] = alpha;
#pragma unroll
        for (int r = 0; r < 16; ++r) { const float a = wsf[crow(r, hi)]; o[0][r] *= a; o[1][r] *= a; lacc[r] *= a; }
    }
    const float nm = -m;
    __builtin_amdgcn_sched_barrier(0);
    const LAS unsigned char* kp = kbn + r32 * kstride + hi * 16;
    constexpr int NM = 2 * ND;
    const f32x16 z16 = (f32x16){0.f, 0.f, 0.f, 0.f, 0.f, 0.f, 0.f, 0.f, 0.f, 0.f, 0.f, 0.f, 0.f, 0.f, 0.f, 0.f};
    bf16x8 kfr[3] = {q[0], q[0], q[0]};
    if constexpr (HAS_NEXT) {
#pragma unroll
        for (int i = 0; i < 3; ++i) kfr[i] = *(const LAS bf16x8*)(kp + (i & 1) * 32 * kstride + (i >> 1) * 32);
    }
#pragma unroll
    for (int i = 0; i < NM; ++i) {
        if constexpr (HAS_NEXT) {
            const int d0 = i >> 1;
            const bf16x8 kf = kfr[i % 3];
            if (i & 1) PB1 = (d0 == 0) ? MFMA32(kf, q[d0], z16) : MFMA32(kf, q[d0], PB1);
            else       PB0 = (d0 == 0) ? MFMA32(kf, q[d0], z16) : MFMA32(kf, q[d0], PB0);
            if (i + 3 < NM) kfr[i % 3] = *(const LAS bf16x8*)(kp + ((i + 3) & 1) * 32 * kstride + ((i + 3) >> 1) * 32);
        }
#pragma unroll
        for (int e = (32 * i) / NM; e < (32 * (i + 1)) / NM; ++e) {
            if (e < 16) PA0[e] = __builtin_amdgcn_exp2f(__builtin_fmaf(PA0[e], SC, nm));
            else PA1[e - 16] = __builtin_amdgcn_exp2f(__builtin_fmaf(PA1[e - 16], SC, nm));
        }
        PIN16(PA0); PIN16(PA1);
        __builtin_amdgcn_sched_barrier(0);
    }
    u32x4 pw[4];
#pragma unroll
    for (int j = 0; j < 4; ++j) { pw[0][j] = cvt_pk_bf16(PA0[2 * j], PA0[2 * j + 1]); pw[1][j] = cvt_pk_bf16(PA0[8 + 2 * j], PA0[8 + 2 * j + 1]);
                                  pw[2][j] = cvt_pk_bf16(PA1[2 * j], PA1[2 * j + 1]); pw[3][j] = cvt_pk_bf16(PA1[8 + 2 * j], PA1[8 + 2 * j + 1]); }
#pragma unroll
    for (int ks = 0; ks < 4; ++ks) lacc = MFMA32(__builtin_bit_cast(bf16x8, pw[ks]), ones, lacc);
    attn_pv(pw, vb, o, lane);
}
template <class Spec>
__device__ __forceinline__ void attn_finish_acc(f32x16 (&o)[2], const f32x16& lacc, const Spec& sp, LAS bf16_t* stg, const int lane) {
    const int r32 = lane & 31, hi = lane >> 5;
#pragma unroll
    for (int r = 0; r < 16; ++r) { const int orow = crow(r, hi); const float rl = __builtin_amdgcn_rcpf(lacc[r]);
        const unsigned w = cvt_pk_bf16(o[0][r] * rl, o[1][r] * rl);
        stg[orow * 64 + r32] = (bf16_t)(w & 0xffffu); stg[orow * 64 + 32 + r32] = (bf16_t)(w >> 16); }
#pragma unroll
    for (int i = 0; i < 4; ++i) { const int row = i * 8 + (lane >> 3), ch = lane & 7; *(u32x4*)(sp.orow(row) + ch * 8) = *(const LAS u32x4*)(stg + row * 64 + ch * 8); }
}

template <class Spec>
__device__ __forceinline__ float attn_finish(f32x16 (&o)[2], const float l, const Spec& sp, LAS float* wsf, LAS bf16_t* stg, const int lane) {
    const int r32 = lane & 31, hi = lane >> 5;
    const float lt = half_sum(l);
    if (hi == 0) wsf[32 + r32] = lt;
#pragma unroll
    for (int r = 0; r < 16; ++r) { const int orow = crow(r, hi); const float rl = 1.0f / wsf[32 + orow];
        const unsigned w = cvt_pk_bf16(o[0][r] * rl, o[1][r] * rl);
        stg[orow * 64 + r32] = (bf16_t)(w & 0xffffu); stg[orow * 64 + 32 + r32] = (bf16_t)(w >> 16); }
#pragma unroll
    for (int i = 0; i < 4; ++i) { const int row = i * 8 + (lane >> 3), ch = lane & 7; *(u32x4*)(sp.orow(row) + ch * 8) = *(const LAS u32x4*)(stg + row * 64 + ch * 8); }
    return lt;
}

constexpr int AW_K = 0, AW_KSTRIDE = 144, AW_V = 9216, AW_WSF = 17408, AW_BIAS = 17664, AW_BYTES = 19712;
static_assert(AW_BYTES * NWAVES <= LDS_BYTES, "attention LDS");

template <class Spec>
__device__ __forceinline__ void attn_wave_item(const Spec& sp, LAS unsigned char* wl, const int lane, float m0, float l0) {
    const int r32 = lane & 31, hi = lane >> 5;
    LAS float* wsf = (LAS float*)(wl + AW_WSF);
    bf16x8 q[4];
    { const bf16_t* qp = sp.qrow(r32);
#pragma unroll
      for (int d0 = 0; d0 < 4; ++d0) q[d0] = *(const bf16x8*)(qp + d0 * 16 + hi * 8); }
    f32x16 o[2];
#pragma unroll
    for (int r = 0; r < 16; ++r) { o[0][r] = 0.f; o[1][r] = 0.f; }
    float m = m0, l = (hi == 0) ? l0 : 0.f;
    int tlo = 0, thi = Spec::NT;
    while (tlo < thi && sp.skip(tlo)) ++tlo;
    while (thi > tlo && sp.skip(thi - 1)) --thi;
    const int lrow = lane >> 3, lc = lane & 7;
    u32x4 kr[8];
#pragma unroll
    for (int j = 0; j < 8; ++j) kr[j] = *(const u32x4*)(sp.kptr(sp.ktok(tlo, j * 8 + lrow)) + lc * 8);
    LAS unsigned char* kw = wl + AW_K + lrow * AW_KSTRIDE + lc * 16; LAS unsigned char* vw = wl + AW_V + (lc >> 2) * 4096 + lrow * 64 + (lc & 3) * 16;
    for (int t = tlo; t < thi; ++t) {
#pragma unroll
        for (int j = 0; j < 8; ++j) *(LAS u32x4*)(kw + j * 8 * AW_KSTRIDE) = kr[j];
#pragma unroll
        for (int j = 0; j < 8; ++j) kr[j] = *(const u32x4*)(sp.vptr(sp.ktok(t, j * 8 + lrow)) + lc * 8);
        u32x4 pw[4];
        attn_scores<4, Spec>(q, wl + AW_K, AW_KSTRIDE, o, m, l, sp, t, wsf, lane, pw);
#pragma unroll
        for (int j = 0; j < 8; ++j) *(LAS u32x4*)(vw + j * 8 * 64) = kr[j];
        if (t + 1 < thi) {
#pragma unroll
            for (int j = 0; j < 8; ++j) kr[j] = *(const u32x4*)(sp.kptr(sp.ktok(t + 1, j * 8 + lrow)) + lc * 8);
        }
        attn_pv(pw, wl + AW_V, o, lane);
    }
    const float lt = attn_finish(o, l, sp, wsf, (LAS bf16_t*)(wl + AW_K), lane);
    sp.finish(m, lt, r32, hi);
}

struct DilSpec {
    static constexpr int NT = 3;
    const bf16_t* proj; const bf16_t* kc; bf16_t* oc; float* lse; int b, r, d, sd, ci0, h, kstart;
    __device__ __forceinline__ const bf16_t* qrow(int row) const { return proj + (size_t)(b * SEQ + (ci0 + row) * d + r) * EVEN_IN + h * 64; }
    __device__ __forceinline__ bool skip(int t) const { const int k0 = kstart + 64 * t; return (k0 + 63 < 0) || (k0 >= sd); }
    __device__ __forceinline__ size_t ktok(int t, int kk) const { const int kj = clampi(kstart + 64 * t + kk, 0, sd - 1), tk = kj * d + r; return (size_t)(b * SEQ + ((tk & 15) << 8) + (tk >> 4)); }
    __device__ __forceinline__ const bf16_t* kptr(size_t row) const { return kc + row * 1024 + h * 64; }
    __device__ __forceinline__ const bf16_t* vptr(size_t row) const { return kc + row * 1024 + 512 + h * 64; }
    static constexpr float SC = 0.125f * LOG2E;
    struct Cx { int a; unsigned w; };
    __device__ __forceinline__ Cx prep(int t, int r32, int hi) const { const int qi = ci0 + r32, lo = qi - 64 > 0 ? qi - 64 : 0, hi_ = qi + 64 < sd - 1 ? qi + 64 : sd - 1; return Cx{kstart + 64 * t + 4 * hi - lo, (unsigned)(hi_ - lo)}; }
    __device__ __forceinline__ float mask(float s, const Cx& cx, int r, int half) const { return ((unsigned)(cx.a + ((r & 3) + 8 * (r >> 2) + 32 * half)) <= cx.w) ? s : -INFINITY; }
    __device__ __forceinline__ bf16_t* orow(int row) const { return oc + (size_t)(b * SEQ + (ci0 + row) * d + r) * 512 + h * 64; }
    __device__ __forceinline__ void finish(float m, float lt, int r32, int hi) const { if (hi == 0) lse[(size_t)(b * SEQ + (ci0 + r32) * d + r) * 8 + h] = m * LN2 + __logf(lt); }
};
struct NaSpec {
    static constexpr int NT = 5;
    const bf16_t* proj; bf16_t* mixed; const LAS float* bias; int b, gr, hf, h, rs, cb;
    __device__ __forceinline__ const bf16_t* qrow(int row) const { return proj + (size_t)(b * SEQ + gr * 64 + 32 * hf + row) * EVEN_IN + 1536 + h * 64; }
    __device__ __forceinline__ bool skip(int) const { return false; }
    __device__ __forceinline__ size_t ktok(int t, int kk) const { return (size_t)(b * SEQ + (rs + (kk >> 3)) * 64 + cb + 8 * t + (kk & 7)); }
    __device__ __forceinline__ const bf16_t* kptr(size_t tok) const { return proj + tok * EVEN_IN + 2048 + h * 64; }
    __device__ __forceinline__ const bf16_t* vptr(size_t tok) const { return proj + tok * EVEN_IN + 2560 + h * 64; }
    static constexpr float SC = 0.125f * LOG2E;
    struct Cx { const LAS float* bp[4]; bool v[4]; };
    __device__ __forceinline__ Cx prep(int t, int r32, int hi) const { Cx c; const int qcol = 32 * hf + r32, ws = clampi(qcol - 8, 0, 48);
#pragma unroll
        for (int j = 0; j < 4; ++j) { const int kcol = cb + 8 * t + j + 4 * hi; c.v[j] = (kcol >= ws) && (kcol < ws + 16); c.bp[j] = bias + (rs - gr + 7) * 31 + clampi(kcol - qcol + 15, 0, 30); }
        return c; }
    __device__ __forceinline__ float mask(float s, const Cx& cx, int r, int half) const { return cx.v[r & 3] ? s + cx.bp[r & 3][31 * ((r >> 2) + 4 * half)] : -INFINITY; }
    __device__ __forceinline__ bf16_t* orow(int row) const { return mixed + (size_t)(b * SEQ + gr * 64 + 32 * hf + row) * DM + 512 + h * 64; }
    __device__ __forceinline__ void finish(float, float, int, int) const {}
};
struct SwaSpec {
    static constexpr int NT = 5;
    const bf16_t* proj; bf16_t* mixed; int b, hq, kvh, q0, kstart;
    __device__ __forceinline__ const bf16_t* qrow(int row) const { return proj + (size_t)(b * SEQ + q0 + row) * ODD_INP + hq * 64; }
    __device__ __forceinline__ bool skip(int t) const { const int k0 = kstart + 64 * t; return (k0 + 63 < 0) || (k0 >= SEQ); }
    __device__ __forceinline__ size_t ktok(int t, int kk) const { return (size_t)(b * SEQ + clampi(kstart + 64 * t + kk, 0, SEQ - 1)); }
    __device__ __forceinline__ const bf16_t* kptr(size_t tok) const { return proj + tok * ODD_INP + 512 + kvh * 64; }
    __device__ __forceinline__ const bf16_t* vptr(size_t tok) const { return proj + tok * ODD_INP + 640 + kvh * 64; }
    static constexpr float SC = 0.125f * LOG2E;
    struct Cx { int a; unsigned w; };
    __device__ __forceinline__ Cx prep(int t, int r32, int hi) const { const int qi = q0 + r32, lo = qi - 128 > 0 ? qi - 128 : 0, hi_ = qi + 128 < SEQ - 1 ? qi + 128 : SEQ - 1; return Cx{kstart + 64 * t + 4 * hi - lo, (unsigned)(hi_ - lo)}; }
    __device__ __forceinline__ float mask(float s, const Cx& cx, int r, int half) const { return ((unsigned)(cx.a + ((r & 3) + 8 * (r >> 2) + 32 * half)) <= cx.w) ? s : -INFINITY; }
    __device__ __forceinline__ bf16_t* orow(int row) const { return mixed + (size_t)(b * SEQ + q0 + row) * DM + hq * 64; }
    __device__ __forceinline__ void finish(float, float, int, int) const {}
};
struct MlaSpec {
    static constexpr float SC = 0.10206207261596577f * LOG2E;
    bf16_t* mixed; int tok0, h;
    __device__ __forceinline__ bf16_t* orow(int row) const { return mixed + (size_t)(tok0 + row) * DM + 512 + h * 64; }
};
constexpr int ML_K0 = 0, ML_KSTRIDE = 208, ML_KB = 13312, ML_V0 = 3 * ML_KB, ML_VB = 8192, ML_WSF = ML_V0 + 3 * ML_VB,
              ML_STG = ML_WSF + NWAVES * 256, ML_BYTES = ML_STG + NWAVES * 4096;
static_assert(ML_BYTES <= LDS_BYTES, "mla LDS");

#define XB_TMO      128
#define XB_XCNT(j)  (256  + 64 * (j))
#define XB_XSUB(j)  (1280 + 64 * (j))
#define XB_XGEN(j)  (2304 + 64 * (j))
#define XB_TOP      3328
#define XB_TOPGEN   3392
#define XCD_BAR_WORDS 3456
#define XB_SPIN_CAP (1u << 18)

__device__ __forceinline__ unsigned xb_ld(unsigned* p)              { return __hip_atomic_load(p, __ATOMIC_RELAXED, __HIP_MEMORY_SCOPE_AGENT); }
__device__ __forceinline__ unsigned xb_add(unsigned* p, unsigned v) { return __hip_atomic_fetch_add(p, v, __ATOMIC_RELAXED, __HIP_MEMORY_SCOPE_AGENT); }
__device__ __forceinline__ unsigned xb_xcc_id() { return (unsigned)__builtin_amdgcn_s_getreg((3 << 11) | 20) & 0xFu; }
#define XB_SPIN(cond, bar) do { unsigned _sp = 0; while (cond) { __builtin_amdgcn_s_sleep(1); \
    if ((++_sp & 255u) == 0u) { if (xb_ld(&(bar)[XB_TMO])) break; if (_sp > XB_SPIN_CAP) { atomicAdd(&(bar)[XB_TMO], 1u); break; } } } } while (0)

struct XcdBarrier {
    unsigned* bar; unsigned x;
    volatile LAS unsigned* st;
};

__device__ __forceinline__ XcdBarrier xcd_barrier_post(unsigned* bar, volatile LAS unsigned* st) {
    XcdBarrier b; b.bar = bar; b.x = xb_xcc_id(); b.st = st;
    if (threadIdx.x == 0) (void)xb_add(&bar[XB_XCNT(b.x)], 1u);
    return b;
}
__device__ __forceinline__ void xcd_barrier_complete(unsigned* bar, unsigned x, unsigned& nloc, unsigned& nx) {
    const unsigned G = gridDim.x * gridDim.y * gridDim.z;
    unsigned sum, cnt, mine, sp = 0u;
    for (;;) {
        sum = 0u; cnt = 0u; mine = 0u;
#pragma unroll
        for (unsigned j = 0; j < 16; ++j) { const unsigned c = xb_ld(&bar[XB_XCNT(j)]); sum += c; cnt += (c > 0u) ? 1u : 0u; mine = (j == x) ? c : mine; }
        if (sum == G) break;
        __builtin_amdgcn_s_sleep(1);
        if ((++sp & 255u) == 0u) { if (xb_ld(&bar[XB_TMO])) break; if (sp > XB_SPIN_CAP) { atomicAdd(&bar[XB_TMO], 1u); break; } }
    }
    nloc = mine > 0u ? mine : 1u; nx = cnt > 0u ? cnt : 1u;
}

__device__ __forceinline__ void xcd_barrier(const XcdBarrier& b) {
    asm volatile("s_waitcnt vmcnt(0)" ::: "memory");
    __syncthreads();
    if (threadIdx.x == 0) {
        unsigned* bar = b.bar;
        __builtin_amdgcn_s_waitcnt(0);
        unsigned nloc = b.st[0], nx = b.st[1];
        if (nloc == 0u) { xcd_barrier_complete(bar, b.x, nloc, nx); b.st[0] = nloc; b.st[1] = nx; }
        const unsigned old = xb_add(&bar[XB_XSUB(b.x)], 1u);
        const unsigned gen = old / nloc;
        if (old + 1u == (gen + 1u) * nloc) {
            __builtin_amdgcn_fence(__ATOMIC_RELEASE, "agent");
            asm volatile("s_waitcnt vmcnt(0)" ::: "memory");
            const unsigned og = xb_add(&bar[XB_TOP], 1u);
            const unsigned tg = og / nx;
            if (og + 1u == (tg + 1u) * nx) xb_add(&bar[XB_TOPGEN], 1u);
            else XB_SPIN(xb_ld(&bar[XB_TOPGEN]) == tg, bar);
            __builtin_amdgcn_fence(__ATOMIC_ACQUIRE, "agent");
            xb_add(&bar[XB_XGEN(b.x)], 1u);
            asm volatile("s_waitcnt vmcnt(0)" ::: "memory");
        } else {
            XB_SPIN(xb_ld(&bar[XB_XGEN(b.x)]) == gen, bar);
            __builtin_amdgcn_fence(__ATOMIC_ACQUIRE, "agent");
            asm volatile("s_waitcnt vmcnt(0)" ::: "memory");
        }
    }
    __syncthreads();
}

struct Args {
    const float* in[21];
    float* out; unsigned char* ws;
    int ph_lo, ph_hi;
};
typedef const __attribute__((address_space(4))) Args CArgs;
enum { I_X = 0, I_F1N, I_F1W1, I_F1W3, I_F1W2, I_MIXN, I_F2N, I_F2W1, I_F2W3, I_F2W2, I_EWIN, I_EWOUT, I_RPB, I_OWIN, I_OWOUT, I_SINK, I_QN, I_WQB, I_KVN, I_WKVB, I_FN };

__device__ __forceinline__ void rmsnorm_rows(const float* h, const float* g, bf16_t* hn, int gw, int NGW, int lane) {
    f32x4 gv[4];
#pragma unroll
    for (int j = 0; j < 4; ++j) gv[j] = ((const f32x4*)g)[lane + 64 * j];
    for (int row = gw; row < T; row += NGW) {
        const f32x4* xr = (const f32x4*)(h + (size_t)row * DM) + lane;
        f32x4 v[4]; float s = 0.f;
#pragma unroll
        for (int j = 0; j < 4; ++j) { v[j] = xr[64 * j]; s += (v[j].x * v[j].x + v[j].y * v[j].y) + (v[j].z * v[j].z + v[j].w * v[j].w); }
        const float rstd = 1.0f / sqrtf(wave_sum(s) * (1.0f / DM) + NORM_EPS);
        u32x2* o8 = (u32x2*)(hn + (size_t)row * DM) + lane;
#pragma unroll
        for (int j = 0; j < 4; ++j) { const f32x4 y = v[j] * rstd * gv[j]; u32x2 w; w.x = cvt_pk_bf16(y.x, y.y); w.y = cvt_pk_bf16(y.z, y.w); o8[64 * j] = w; }
    }
}
__device__ __forceinline__ void load_row_bf16(const bf16_t* hrow, int lane, float (&x)[16]) {
    const u32x4 a = ((const u32x4*)hrow)[lane], b = ((const u32x4*)hrow)[64 + lane];
#pragma unroll
    for (int j = 0; j < 4; ++j) { x[2 * j] = f16_lo(a[j]); x[2 * j + 1] = f16_hi(a[j]); x[8 + 2 * j] = f16_lo(b[j]); x[8 + 2 * j + 1] = f16_hi(b[j]); }
}
__device__ __forceinline__ void rmsnorm_rows_bf16(const bf16_t* h, const float* g, bf16_t* hn, int gw, int NGW, int lane) {
    float gv[16];
#pragma unroll
    for (int j = 0; j < 8; ++j) { gv[j] = g[lane * 8 + j]; gv[8 + j] = g[512 + lane * 8 + j]; }
    for (int row = gw; row < T; row += NGW) {
        float x[16]; load_row_bf16(h + (size_t)row * DM, lane, x);
        float s = 0.f;
#pragma unroll
        for (int j = 0; j < 16; ++j) s += x[j] * x[j];
        const float rstd = 1.0f / sqrtf(wave_sum(s) * (1.0f / DM) + NORM_EPS);
        u32x4 a, b;
#pragma unroll
        for (int j = 0; j < 4; ++j) { a[j] = cvt_pk_bf16(x[2 * j] * rstd * gv[2 * j], x[2 * j + 1] * rstd * gv[2 * j + 1]); b[j] = cvt_pk_bf16(x[8 + 2 * j] * rstd * gv[8 + 2 * j], x[8 + 2 * j + 1] * rstd * gv[8 + 2 * j + 1]); }
        ((u32x4*)(hn + (size_t)row * DM))[lane] = a; ((u32x4*)(hn + (size_t)row * DM))[64 + lane] = b;
    }
}
__device__ __forceinline__ void final_norm_rows(const bf16_t* h, float* out, const float* g, int gw, int NGW, int lane) {
    float gv[16];
#pragma unroll
    for (int j = 0; j < 8; ++j) { gv[j] = g[lane * 8 + j]; gv[8 + j] = g[512 + lane * 8 + j]; }
    for (int row = gw; row < T; row += NGW) {
        float x[16]; load_row_bf16(h + (size_t)row * DM, lane, x);
        float s = 0.f;
#pragma unroll
        for (int j = 0; j < 16; ++j) s += x[j] * x[j];
        const float rstd = 1.0f / sqrtf(wave_sum(s) * (1.0f / DM) + NORM_EPS);
        float* orow = out + (size_t)row * DM;
#pragma unroll
        for (int j = 0; j < 2; ++j) {
            *(f32x4*)(orow + lane * 8 + 4 * j) = (f32x4){x[4 * j] * rstd * gv[4 * j], x[4 * j + 1] * rstd * gv[4 * j + 1], x[4 * j + 2] * rstd * gv[4 * j + 2], x[4 * j + 3] * rstd * gv[4 * j + 3]};
            *(f32x4*)(orow + 512 + lane * 8 + 4 * j) = (f32x4){x[8 + 4 * j] * rstd * gv[8 + 4 * j], x[8 + 4 * j + 1] * rstd * gv[8 + 4 * j + 1], x[8 + 4 * j + 2] * rstd * gv[8 + 4 * j + 2], x[8 + 4 * j + 3] * rstd * gv[8 + 4 * j + 3]}; }
    }
}
__device__ __forceinline__ void transpose_item(const float* W, int srcN, int k0, int sc0, bf16_t* WT, int K, int dr0, LAS float* scr, int lane) {
#pragma unroll 8
    for (int i = 0; i < 32; ++i) { const int kk = 2 * i + (lane >> 5); scr[kk * 33 + (lane & 31)] = W[(size_t)(k0 + kk) * srcN + sc0 + (lane & 31)]; }
    asm volatile("s_waitcnt lgkmcnt(0)" ::: "memory");
    const int c = lane & 7;
#pragma unroll
    for (int j = 0; j < 4; ++j) { const int n = (lane >> 3) + 8 * j; const LAS float* s = scr + (8 * c) * 33 + n;
        u32x4 o; o.x = cvt_pk_bf16(s[0 * 33], s[1 * 33]); o.y = cvt_pk_bf16(s[2 * 33], s[3 * 33]); o.z = cvt_pk_bf16(s[4 * 33], s[5 * 33]); o.w = cvt_pk_bf16(s[6 * 33], s[7 * 33]);
        *(u32x4*)(WT + (size_t)(dr0 + n) * K + k0 + 8 * c) = o; }
    asm volatile("s_waitcnt lgkmcnt(0)" ::: "memory");
}
__device__ __forceinline__ void tr_plain(const float* W, int K, int N, bf16_t* WT, int item, LAS float* scr, int lane) {
    const int nblk = N / 32, kb = item / nblk, nb = item % nblk;
    transpose_item(W, N, 64 * kb, 32 * nb, WT, K, 32 * nb, scr, lane);
}
__device__ __forceinline__ void tr_up(const float* w1, const float* w3, bf16_t* WT, int item, LAS float* scr, int lane) {
    constexpr int nrb = 2 * FF / 32; const int kb = item / nrb, rb = item % nrb, pn = rb >> 3, within = rb & 7, half = within >> 2, sub = within & 3;
    transpose_item(half ? w3 : w1, FF, 64 * kb, pn * 128 + sub * 32, WT, DM, 32 * rb, scr, lane);
}

__device__ __forceinline__ void sincos_d(double a, double& s, double& c) {
    const double k = rint(a * 0.63661977236758134308);
    double r = fma(-k, 1.57079632679489655800e+00, a); r = fma(-k, 6.12323399573676603587e-17, r);
    const double r2 = r * r;
    double sp = 1.0 / 6227020800.0; sp = fma(sp, r2, -1.0 / 39916800.0); sp = fma(sp, r2, 1.0 / 362880.0); sp = fma(sp, r2, -1.0 / 5040.0); sp = fma(sp, r2, 1.0 / 120.0); sp = fma(sp, r2, -1.0 / 6.0);
    const double sr = fma(sp * r2, r, r);
    double cp = -1.0 / 87178291200.0; cp = fma(cp, r2, 1.0 / 479001600.0); cp = fma(cp, r2, -1.0 / 3628800.0); cp = fma(cp, r2, 1.0 / 40320.0); cp = fma(cp, r2, -1.0 / 720.0); cp = fma(cp, r2, 1.0 / 24.0); cp = fma(cp, r2, -0.5);
    const double cr = fma(cp, r2, 1.0);
    const int qd = ((int)k) & 3;
    s = (qd == 0) ? sr : (qd == 1) ? cr : (qd == 2) ? -sr : -cr;
    c = (qd == 0) ? cr : (qd == 1) ? -sr : (qd == 2) ? -cr : sr;
}

__device__ __forceinline__ void rope8(u32x4& a, u32x4& b, const float* cs, const float* sn, int st) {
    u32x4 ra, rb;
#pragma unroll
    for (int j = 0; j < 4; ++j) {
        const float x1l = bf_lo(a[j]), x1h = bf_hi(a[j]), x2l = bf_lo(b[j]), x2h = bf_hi(b[j]);
        const float cl = cs[(2 * j) * st], ch = cs[(2 * j + 1) * st], sl = sn[(2 * j) * st], sh = sn[(2 * j + 1) * st];
        ra[j] = cvt_pk_bf16(x1l * cl - x2l * sl, x1h * ch - x2h * sh);
        rb[j] = cvt_pk_bf16(x2l * cl + x1l * sl, x2h * ch + x1h * sh);
    }
    a = ra; b = rb;
}

__device__ __forceinline__ void rope8_fly(u32x4& a, u32x4& b, const float pos, const int i0) {
    u32x4 ra, rb;
#pragma unroll
    for (int j = 0; j < 4; ++j) {
        float cs[2], sn[2];
#pragma unroll
        for (int e = 0; e < 2; ++e) { const float rev = __builtin_amdgcn_fractf(pos * (__builtin_amdgcn_exp2f((float)(i0 + 2 * j + e) * (-13.287712379549449f / 32.0f)) * 0.15915494309189535f));
            sn[e] = __builtin_amdgcn_sinf(rev); cs[e] = __builtin_amdgcn_cosf(rev); }
        const float x1l = bf_lo(a[j]), x1h = bf_hi(a[j]), x2l = bf_lo(b[j]), x2h = bf_hi(b[j]);
        ra[j] = cvt_pk_bf16(x1l * cs[0] - x2l * sn[0], x1h * cs[1] - x2h * sn[1]);
        rb[j] = cvt_pk_bf16(x2l * cs[0] + x1l * sn[0], x2h * cs[1] + x1h * sn[1]);
    }
    a = ra; b = rb;
}

__global__ void __launch_bounds__(NTHREADS, 2) fwd_megakernel(Args args) {
    extern __shared__ __attribute__((aligned(16))) unsigned char lds_raw[];
    LAS unsigned char* lds = (LAS unsigned char*)lds_raw;
    cg::grid_group grid = cg::this_grid();
    const int G = gridDim.x, NGW = G * NWAVES;
    unsigned char* ws0 = args.ws;
    volatile LAS unsigned* bst = (volatile LAS unsigned*)(lds + LDS_BYTES - 64);
    if (threadIdx.x < 16) bst[threadIdx.x] = 0u;
    __syncthreads();
    const XcdBarrier xbar = xcd_barrier_post((unsigned*)(ws0 + WS_BAR), bst);

    if (args.ph_lo == 0) {
        float* cosT = (float*)(ws0 + WS_COS); float* sinT = (float*)(ws0 + WS_SIN);
        for (int e = blockIdx.x * NTHREADS + threadIdx.x; e < SEQ * 32; e += G * NTHREADS) {
            const int pos = e >> 5, i = e & 31; double s, c; sincos_d((double)pos * exp2((double)i * (-13.287712379549449 / 32.0)), s, c); cosT[e] = (float)c; sinT[e] = (float)s; }
    }
#ifndef PROBE_DUP
#define PROBE_DUP 0
#endif
    bool dup_done = false; (void)dup_done;
    for (int ph = args.ph_lo; ph < args.ph_hi; ++ph) {
        int tid = threadIdx.x; asm volatile("" : "+v"(tid));
        int bid = blockIdx.x; asm volatile("" : "+s"(bid));
        const CArgs* ap = (const CArgs*)__builtin_amdgcn_kernarg_segment_ptr(); asm volatile("" : "+s"(ap));
        const int lane = tid & 63, wave = __builtin_amdgcn_readfirstlane(tid >> 6), gw = bid * NWAVES + wave;
        unsigned char* ws = ap->ws; float* hres = ap->out;
        float* cosT = (float*)(ws + WS_COS); float* sinT = (float*)(ws + WS_SIN);
        bf16_t* hn = (bf16_t*)(ws + WS_HN); bf16_t* mixed = hn;
        bf16_t* hbf = (bf16_t*)(ws + WS_NAO);
        bf16_t* big = (bf16_t*)(ws + WS_BIG);
        bf16_t* oc = (bf16_t*)(ws + WS_AUX); float* lse = (float*)(ws + WS_AUX + AUX_LSE);
        bf16_t* qmla = (bf16_t*)(ws + WS_AUX); bf16_t* kvmla = (bf16_t*)(ws + WS_AUX + AUX_KV);
        const int li = ph / 12, st = ph % 12, jj = li >> 1; const bool even = (li & 1) == 0;
        if (ph < DEPTH * 12 && even && st == 5) continue;
        if (ph == DEPTH * 12) {
            final_norm_rows(hbf, hres, ap->in[I_FN], gw, NGW, lane);
        } else if (st == 0) {
            LAS float* scr = (LAS float*)(lds + wave * 8448);
            constexpr int I_UP = (DM / 64) * (2 * FF / 32), I_DN = (FF / 64) * (DM / 32), I_EIN = (DM / 64) * (EVEN_IN / 32), I_OIN = (DM / 64) * (ODD_IN / 32), I_OUT = (DM / 64) * (DM / 32),
                          I_QBI = (384 / 64) * (768 / 32), I_KVBI = (256 / 64) * (1024 / 32), I_PAD = ODD_INP - ODD_IN;
            const int n_in = even ? I_EIN : I_OIN;
            const int total = 2 * I_UP + 2 * I_DN + n_in + I_OUT + (even ? 0 : (I_QBI + I_KVBI + I_PAD));
            const size_t wff = (size_t)li * DM * FF;
            for (int it = gw; it < total; it += NGW) {
                int r = it;
                if (r < I_UP) { tr_up(ap->in[I_F1W1] + wff, ap->in[I_F1W3] + wff, (bf16_t*)(ws + W_UP1), r, scr, lane); continue; } r -= I_UP;
                if (r < I_UP) { tr_up(ap->in[I_F2W1] + wff, ap->in[I_F2W3] + wff, (bf16_t*)(ws + W_UP2), r, scr, lane); continue; } r -= I_UP;
                if (r < I_DN) { tr_plain(ap->in[I_F1W2] + wff, FF, DM, (bf16_t*)(ws + W_DN1), r, scr, lane); continue; } r -= I_DN;
                if (r < I_DN) { tr_plain(ap->in[I_F2W2] + wff, FF, DM, (bf16_t*)(ws + W_DN2), r, scr, lane); continue; } r -= I_DN;
                if (r < n_in) { if (even) tr_plain(ap->in[I_EWIN] + (size_t)jj * DM * EVEN_IN, DM, EVEN_IN, (bf16_t*)(ws + W_IN), r, scr, lane);
                                else tr_plain(ap->in[I_OWIN] + (size_t)jj * DM * ODD_IN, DM, ODD_IN, (bf16_t*)(ws + W_IN), r, scr, lane); continue; } r -= n_in;
                if (r < I_OUT) { tr_plain((even ? ap->in[I_EWOUT] : ap->in[I_OWOUT]) + (size_t)jj * DM * DM, DM, DM, (bf16_t*)(ws + W_OUT), r, scr, lane); continue; } r -= I_OUT;
                if (r < I_QBI) { tr_plain(ap->in[I_WQB] + (size_t)jj * 384 * 768, 384, 768, (bf16_t*)(ws + W_QB), r, scr, lane); continue; } r -= I_QBI;
                if (r < I_KVBI) { tr_plain(ap->in[I_WKVB] + (size_t)jj * 256 * 1024, 256, 1024, (bf16_t*)(ws + W_KVB), r, scr, lane); continue; } r -= I_KVBI;
                { u32x4* z = (u32x4*)((bf16_t*)(ws + W_IN) + (size_t)(ODD_IN + r) * DM); z[lane] = (u32x4){0u, 0u, 0u, 0u}; z[64 + lane] = (u32x4){0u, 0u, 0u, 0u}; }
            }
            if (li == 0) rmsnorm_rows(ap->in[I_X], ap->in[I_F1N], hn, gw, NGW, lane); else rmsnorm_rows_bf16(hbf, ap->in[I_F1N] + li * DM, hn, gw, NGW, lane);
        } else if (st == 1 || st == 10) {
            pg8::Gemm g{hn, (const bf16_t*)(ws + (st == 1 ? W_UP1 : W_UP2)), T, 2 * FF, DM, DM}; pg8::StaticOrder S; S.init(T, 2 * FF, G, bid);
            pg8::EpiSwiglu E{big, FF};
            pg8::gemm_phase<pg8::EpiSwiglu, pg8::StaticOrder>(lds, g, S, E, tid);
        } else if (st == 2 || st == 11) {
            pg8::Gemm g{big, (const bf16_t*)(ws + (st == 2 ? W_DN1 : W_DN2)), T, DM, FF, FF}; pg8::StaticOrder S; S.init(T, DM, G, bid);
            pg8::EpiResid E{(li == 0 && st == 2) ? ap->in[I_X] : (const float*)nullptr, hbf, DM, 0.5f};
            pg8::gemm_phase<pg8::EpiResid, pg8::StaticOrder>(lds, g, S, E, tid);
        } else if (st == 3 || st == 9) {
            rmsnorm_rows_bf16(hbf, (st == 3 ? ap->in[I_MIXN] : ap->in[I_F2N]) + li * DM, hn, gw, NGW, lane);
        } else if (st == 4) {
            const int N = even ? EVEN_IN : ODD_INP;
            pg8::Gemm g{hn, (const bf16_t*)(ws + W_IN), T, N, DM, DM}; pg8::StaticOrder S; S.init(T, N, G, bid);
            pg8::EpiBf16 E{big, N};
            pg8::gemm_phase<pg8::EpiBf16, pg8::StaticOrder>(lds, g, S, E, tid);
        } else if (st == 5) {
            if (even) {
                for (int row = gw; row < T; row += NGW) {
                    const int pos = row & (SEQ - 1); bf16_t* p = big + (size_t)row * EVEN_IN + (lane >> 2) * 64 + (lane & 3) * 8;
                    const u32x4 va = *(const u32x4*)(big + (size_t)row * EVEN_IN + 1024 + lane * 8);
                    u32x4 a = *(const u32x4*)p, b = *(const u32x4*)(p + 32);
                    rope8(a, b, cosT + pos * 32 + (lane & 3) * 8, sinT + pos * 32 + (lane & 3) * 8, 1);
                    bf16_t* kcr = hn + ((size_t)(row - pos) + ((pos & 15) << 8) + (pos >> 4)) * 1024;
                    if (lane < 32) { *(u32x4*)p = a; *(u32x4*)(p + 32) = b; }
                    else { bf16_t* kq = kcr + ((lane >> 2) - 8) * 64 + (lane & 3) * 8; *(u32x4*)kq = a; *(u32x4*)(kq + 32) = b; }
                    *(u32x4*)(kcr + 512 + lane * 8) = va;
                }
            } else {
                const float* qn = ap->in[I_QN] + jj * 384; const float* kvn = ap->in[I_KVN] + jj * 256;
                for (int row = gw; row < T; row += NGW) {
                    const int pos = row & (SEQ - 1); bf16_t* pr = big + (size_t)row * ODD_INP;
                    if (lane < 40) {
                        bf16_t* p = pr + (lane >> 2) * 64 + (lane & 3) * 8;
                        u32x4 a = *(const u32x4*)p, b = *(const u32x4*)(p + 32);
                        rope8(a, b, cosT + pos * 32 + (lane & 3) * 8, sinT + pos * 32 + (lane & 3) * 8, 1);
                        *(u32x4*)p = a; *(u32x4*)(p + 32) = b;
                    } else if (lane < 42) {
                        bf16_t* p = pr + 1408 + (lane - 40) * 8;
                        u32x4 a = *(const u32x4*)p, b = *(const u32x4*)(p + 16);
                        rope8(a, b, cosT + pos * 32 + (lane - 40) * 16, sinT + pos * 32 + (lane - 40) * 16, 2);
                        *(u32x4*)p = a; *(u32x4*)(p + 16) = b;
                    }
                    u32x4 qa = (u32x4){0u, 0u, 0u, 0u}, ka = (u32x4){0u, 0u, 0u, 0u};
                    if (lane < 48) qa = *(const u32x4*)(pr + 768 + lane * 8);
                    if (lane < 32) ka = *(const u32x4*)(pr + 1152 + lane * 8);
                    float sq = 0.f, sk = 0.f;
#pragma unroll
                    for (int j = 0; j < 4; ++j) { const float a0 = bf_lo(qa[j]), a1 = bf_hi(qa[j]), b0 = bf_lo(ka[j]), b1 = bf_hi(ka[j]); sq += a0 * a0 + a1 * a1; sk += b0 * b0 + b1 * b1; }
                    const float rq = 1.0f / sqrtf(wave_sum(sq) * (1.0f / 384.0f) + NORM_EPS), rk = 1.0f / sqrtf(wave_sum(sk) * (1.0f / 256.0f) + NORM_EPS);
                    if (lane < 48) { u32x4 w;
#pragma unroll
                        for (int j = 0; j < 4; ++j) w[j] = cvt_pk_bf16(bf_lo(qa[j]) * rq * qn[lane * 8 + 2 * j], bf_hi(qa[j]) * rq * qn[lane * 8 + 2 * j + 1]);
                        *(u32x4*)(pr + 768 + lane * 8) = w; }
                    if (lane < 32) { u32x4 w;
#pragma unroll
                        for (int j = 0; j < 4; ++j) w[j] = cvt_pk_bf16(bf_lo(ka[j]) * rk * kvn[lane * 8 + 2 * j], bf_hi(ka[j]) * rk * kvn[lane * 8 + 2 * j + 1]);
                        *(u32x4*)(pr + 1152 + lane * 8) = w; }
                }
            }
        } else if (st == 6) {
            if (even) {
                LAS unsigned char* wl = lds + wave * AW_BYTES;
                constexpr int NDIL = 3 * 8192, NNA = 8192;
                const float* rpb = ap->in[I_RPB] + (size_t)jj * 8 * 465;
                const int vcu = (G % 8 == 0) ? (bid % 8) * (G / 8) + bid / 8 : bid;
                const int h = wave;
                { constexpr int DK_KSTR = 144, DK_VHS = 416 * 64, DK_V = 416 * DK_KSTR, DK_WSF = DK_V + 2 * DK_VHS, DK_STG = DK_WSF + NWAVES * 256;
                  static_assert(DK_STG + NWAVES * 4096 <= LDS_BYTES - 64, "dilated LDS");
                  const int WPW = (3072 + G - 1) / G, w1 = (vcu + 1) * WPW < 3072 ? (vcu + 1) * WPW : 3072;
                  const int r32 = lane & 31, hi = lane >> 5;
                  { unsigned zz = 0u; asm volatile("" : "+v"(zz)); const u32x4 z4 = (u32x4){zz, zz, zz, zz};
                    if (tid < 288) *(LAS u32x4*)(lds + 384 * DK_KSTR + tid * 16) = z4;
                    if (tid < 256) *(LAS u32x4*)(lds + DK_V + (tid >> 7) * DK_VHS + 384 * 64 + (tid & 127) * 16) = z4; }
                  for (int wi = vcu * WPW; wi < w1; ++wi) {
                    const int hh_ = wi & 7, x16 = (wi >> 3) & 15, b = (wi >> 7) & 7, c = wi >> 10;
                    const int d = (c == 0) ? 1 : (c == 1) ? 4 : 16, nb = 16 / d, r = x16 / nb, ib = x16 % nb, sd = SEQ / d;
                    const int kb0 = 256 * ib - 64;
                    u32x4 ka[3], kb_[3], vreg[6];
                    const bf16_t* pb = big + (size_t)(b * SEQ) * EVEN_IN + hh_ * 64;
#pragma unroll
                    for (int j = 0; j < 3; ++j) { const int idx = tid + 512 * j, row = idx >> 2, c4 = idx & 3; const int tk = clampi(kb0 + row, 0, sd - 1) * d + r;
                        const bf16_t* gp = pb + (size_t)tk * EVEN_IN + 512 + c4 * 8; ka[j] = *(const u32x4*)gp; kb_[j] = *(const u32x4*)(gp + 32); }
#pragma unroll
                    for (int j = 0; j < 6; ++j) { const int idx = tid + 512 * j, row = idx >> 3, cc = idx & 7; const int tk = clampi(kb0 + row, 0, sd - 1) * d + r;
                        vreg[j] = *(const u32x4*)(pb + (size_t)tk * EVEN_IN + 1024 + cc * 8); }
                    const int ci0 = 256 * ib + 32 * wave;
                    DilSpec sp{big, hn, oc + (size_t)c * T * 512, lse + (size_t)c * T * 8, b, r, d, sd, ci0, hh_, ci0 - 64};
                    bf16x8 q[4];
                    { const bf16_t* qp = sp.qrow(r32);
#pragma unroll
                      for (int d0 = 0; d0 < 4; ++d0) q[d0] = *(const bf16x8*)(qp + d0 * 16 + hi * 8); }
                    __syncthreads();
#pragma unroll
                    for (int j = 0; j < 3; ++j) { const int idx = tid + 512 * j, row = idx >> 2, c4 = idx & 3; const int tk = clampi(kb0 + row, 0, sd - 1) * d + r;
                        rope8_fly(ka[j], kb_[j], (float)tk, c4 * 8);
                        *(LAS u32x4*)(lds + row * DK_KSTR + c4 * 16) = ka[j]; *(LAS u32x4*)(lds + row * DK_KSTR + (c4 + 4) * 16) = kb_[j]; }
#pragma unroll
                    for (int j = 0; j < 6; ++j) { const int idx = tid + 512 * j, row = idx >> 3, cc = idx & 7;
                        *(LAS u32x4*)(lds + DK_V + (cc >> 2) * DK_VHS + row * 64 + (cc & 3) * 16) = vreg[j]; }
                    { const float qpos = (float)((ci0 + r32) * d + r);
                      u32x4 a0 = __builtin_bit_cast(u32x4, q[0]), b0 = __builtin_bit_cast(u32x4, q[2]), a1 = __builtin_bit_cast(u32x4, q[1]), b1 = __builtin_bit_cast(u32x4, q[3]);
                      rope8_fly(a0, b0, qpos, 8 * hi); rope8_fly(a1, b1, qpos, 16 + 8 * hi);
                      q[0] = __builtin_bit_cast(bf16x8, a0); q[2] = __builtin_bit_cast(bf16x8, b0); q[1] = __builtin_bit_cast(bf16x8, a1); q[3] = __builtin_bit_cast(bf16x8, b1); }
                    f32x16 o[2];
#pragma unroll
                    for (int rr = 0; rr < 16; ++rr) { o[0][rr] = 0.f; o[1][rr] = 0.f; }
                    float m = -INFINITY, l = 0.f;
                    LAS float* wsf = (LAS float*)(lds + DK_WSF + wave * 256);
                    __syncthreads();
                    for (int t = 0; t < 3; ++t) {
                        if (sp.skip(t)) continue;
                        const int ro = 32 * wave + 64 * t;
                        u32x4 pw[4];
                        attn_scores<4, DilSpec>(q, lds + ro * DK_KSTR, DK_KSTR, o, m, l, sp, t, wsf, lane, pw);
                        attn_pv(pw, lds + DK_V + ro * 64, o, lane, DK_VHS);
                    }
                    const float lt = attn_finish(o, l, sp, wsf, (LAS bf16_t*)(lds + DK_STG + wave * 4096), lane);
                    sp.finish(m, lt, r32, hi);
                  }
                  __syncthreads(); }
                { constexpr int NK_ROWS = 120, NK_KSTR = 144, NK_VHS = NK_ROWS * 64, NK_KB = NK_ROWS * NK_KSTR, NK_BUF = NK_KB + 2 * NK_VHS, NK_WSF = 2 * NK_BUF, NK_BIAS = NK_WSF + NWAVES * 256, NK_STG = NK_BIAS + 2048;
                  static_assert(NK_STG + NWAVES * 4096 <= LDS_BYTES - 64, "neighbourhood LDS");
                  const int WPW = (1024 + G - 1) / G, w1 = (vcu + 1) * WPW < 1024 ? (vcu + 1) * WPW : 1024;
                  const int r32 = lane & 31, hi = lane >> 5;
                  for (int wi = vcu * WPW; wi < w1; ++wi) {
                    const int hh_ = wi & 7, g8 = (wi >> 3) & 7, hf = (wi >> 6) & 1, b = wi >> 7;
                    const int gr = 8 * g8 + wave, rsw = clampi(gr - 4, 0, 56), rmin = clampi(8 * g8 - 4, 0, 56), rmax = clampi(8 * g8 + 3, 0, 56) + 7, nch = (rmax - rmin + 1) * 64;
                    const int cb = hf ? 24 : 0;
                    const bf16_t* kvb = big + (size_t)(b * SEQ) * EVEN_IN + hh_ * 64;
                    u32x4 kreg[2], vreg[2];
#define NK_LOAD(tt) do { _Pragma("unroll") for (int j = 0; j < 2; ++j) { const int idx = tid + 512 * j; if (idx < nch) { const int row = idx >> 3, cc = idx & 7; \
                        const bf16_t* gp = kvb + (size_t)((rmin + (row >> 3)) * 64 + cb + 8 * (tt) + (row & 7)) * EVEN_IN + cc * 8; kreg[j] = *(const u32x4*)(gp + 2048); vreg[j] = *(const u32x4*)(gp + 2560); } } } while (0)
#define NK_STORE(bf) do { _Pragma("unroll") for (int j = 0; j < 2; ++j) { const int idx = tid + 512 * j; if (idx < nch) { const int row = idx >> 3, cc = idx & 7; \
                        *(LAS u32x4*)(lds + (bf) * NK_BUF + row * NK_KSTR + cc * 16) = kreg[j]; *(LAS u32x4*)(lds + (bf) * NK_BUF + NK_KB + (cc >> 2) * NK_VHS + row * 64 + (cc & 3) * 16) = vreg[j]; } } } while (0)
                    NK_LOAD(0);
                    LAS float* bt = (LAS float*)(lds + NK_BIAS);
                    NaSpec sp{big, mixed, bt, b, gr, hf, hh_, rsw, cb};
                    bf16x8 q[4];
                    { const bf16_t* qp = sp.qrow(r32);
#pragma unroll
                      for (int d0 = 0; d0 < 4; ++d0) q[d0] = *(const bf16x8*)(qp + d0 * 16 + hi * 8); }
                    const float bv = (tid < 465) ? 8.0f * rpb[hh_ * 465 + tid] : 0.f;
                    __syncthreads();
                    NK_STORE(0); if (tid < 465) bt[tid] = bv;
                    NK_LOAD(1);
                    f32x16 o[2];
#pragma unroll
                    for (int rr = 0; rr < 16; ++rr) { o[0][rr] = 0.f; o[1][rr] = 0.f; }
                    float m = -INFINITY, l = 0.f;
                    LAS float* wsf = (LAS float*)(lds + NK_WSF + wave * 256);
                    const int ro = (rsw - rmin) * 8;
                    __syncthreads();
                    for (int t = 0; t < 5; ++t) {
                        const int cur = t & 1;
                        if (t + 1 < 5) NK_STORE(cur ^ 1);
                        if (t + 2 < 5) NK_LOAD(t + 2);
                        u32x4 pw[4];
                        attn_scores<4, NaSpec>(q, lds + cur * NK_BUF + ro * NK_KSTR, NK_KSTR, o, m, l, sp, t, wsf, lane, pw);
                        attn_pv(pw, lds + cur * NK_BUF + NK_KB + ro * 64, o, lane, NK_VHS);
                        __syncthreads();
                    }
                    attn_finish(o, l, sp, wsf, (LAS bf16_t*)(lds + NK_STG + wave * 4096), lane);
#undef NK_LOAD
#undef NK_STORE
                  }
                  __syncthreads(); }
            } else {
                { pg8::Gemm g{big + 768, (const bf16_t*)(ws + W_QB), T, 768, 384, ODD_INP}; pg8::StaticOrder S; S.init(T, 768, G, bid);
                  pg8::EpiBf16 E{qmla, 768}; pg8::gemm_phase<pg8::EpiBf16, pg8::StaticOrder>(lds, g, S, E, tid); }
                { pg8::Gemm g{big + 1152, (const bf16_t*)(ws + W_KVB), T, 1024, 256, ODD_INP}; pg8::StaticOrder S; S.init(T, 1024, G, bid);
                  pg8::EpiBf16 E{kvmla, 1024}; pg8::gemm_phase<pg8::EpiBf16, pg8::StaticOrder>(lds, g, S, E, tid); }
            }
        } else if (st == 7) {
            if (even) {
                for (int row = gw; row < T; row += NGW) {
                    const int h = lane >> 3;
                    const float l0 = lse[(size_t)row * 8 + h], l1 = lse[(size_t)T * 8 + (size_t)row * 8 + h], l2 = lse[(size_t)2 * T * 8 + (size_t)row * 8 + h];
                    const float mx = fmaxf(l0, fmaxf(l1, l2)); float w0 = __expf(l0 - mx), w1 = __expf(l1 - mx), w2 = __expf(l2 - mx); const float inv = 1.0f / (w0 + w1 + w2); w0 *= inv; w1 *= inv; w2 *= inv;
                    const u32x4 a = *(const u32x4*)(oc + (size_t)row * 512 + lane * 8), b = *(const u32x4*)(oc + (size_t)T * 512 + (size_t)row * 512 + lane * 8), c = *(const u32x4*)(oc + (size_t)2 * T * 512 + (size_t)row * 512 + lane * 8);
                    u32x4 w;
#pragma unroll
                    for (int j = 0; j < 4; ++j) w[j] = cvt_pk_bf16(w0 * bf_lo(a[j]) + w1 * bf_lo(b[j]) + w2 * bf_lo(c[j]), w0 * bf_hi(a[j]) + w1 * bf_hi(b[j]) + w2 * bf_hi(c[j]));
                    *(u32x4*)(mixed + (size_t)row * DM + lane * 8) = w;
                }
            } else {

#if EN_MLA
                for (int u = bid; u < 1024; u += G) {
                    const int h = u & 7, qb = (u >> 3) & 15, b = u >> 7;
                    const int r32 = lane & 31, hi = lane >> 5;
                    const int tok0 = b * SEQ + 256 * qb + 32 * wave;
                    bf16x8 q[6];
                    { const bf16_t* qp = qmla + (size_t)(tok0 + r32) * 768 + h * 96;
#pragma unroll
                      for (int d0 = 0; d0 < 6; ++d0) q[d0] = *(const bf16x8*)(qp + d0 * 16 + hi * 8);
                      const int pos = (tok0 + r32) & (SEQ - 1);
                      u32x4 a = __builtin_bit_cast(u32x4, q[4]), bb = __builtin_bit_cast(u32x4, q[5]);
                      rope8(a, bb, cosT + pos * 32 + hi * 16, sinT + pos * 32 + hi * 16, 2);
                      q[4] = __builtin_bit_cast(bf16x8, a); q[5] = __builtin_bit_cast(bf16x8, bb); }
                    f32x16 o[2];
#pragma unroll
                    for (int r = 0; r < 16; ++r) { o[0][r] = 0.f; o[1][r] = 0.f; }
                    float m = -INFINITY;
                    f32x16 lacc;
#pragma unroll
                    for (int r = 0; r < 16; ++r) lacc[r] = 0.f;
                    unsigned on_ = 0x3F803F80u; asm volatile("" : "+v"(on_));
                    const bf16x8 ones = __builtin_bit_cast(bf16x8, (u32x4){on_, on_, on_, on_});
                    MlaSpec sp{mixed, tok0, h};
                    LAS float* wsf = (LAS float*)(lds + ML_WSF + wave * 256);
                    const int krow = tid >> 3, kc = tid & 7, prow = (tid & 255) >> 2, pc = tid & 3;
                    const bf16_t* kvp = kvmla + (size_t)(b * SEQ + krow) * 1024 + h * 128 + kc * 8;
                    const bf16_t* pep = big + (size_t)(b * SEQ + prow) * ODD_INP + 1408 + pc * 8;
                    u32x4 kn, vv, pe = (u32x4){0u, 0u, 0u, 0u};
#define MLA_LOAD(tt) do { kn = *(const u32x4*)(kvp + (size_t)(tt) * 64 * 1024); vv = *(const u32x4*)(kvp + (size_t)(tt) * 64 * 1024 + 64); if (tid < 256) pe = *(const u32x4*)(pep + (size_t)(tt) * 64 * ODD_INP); } while (0)
#define MLA_STORE(slot) do { *(LAS u32x4*)(lds + ML_K0 + (slot) * ML_KB + krow * ML_KSTRIDE + kc * 16) = kn; *(LAS u32x4*)(lds + ML_V0 + (slot) * ML_VB + (kc >> 2) * 4096 + krow * 64 + (kc & 3) * 16) = vv; \
                        if (tid < 256) *(LAS u32x4*)(lds + ML_K0 + (slot) * ML_KB + prow * ML_KSTRIDE + 128 + pc * 16) = pe; } while (0)
                    MLA_LOAD(0);
                    __syncthreads();
                    MLA_STORE(0); MLA_LOAD(1); MLA_STORE(1); MLA_LOAD(2);
                    __syncthreads();
                    f32x16 pA0, pA1, pB0, pB1;
                    { const LAS unsigned char* kp = lds + ML_K0 + r32 * ML_KSTRIDE + hi * 16;
#pragma unroll
                      for (int r = 0; r < 16; ++r) { pA0[r] = 0.f; pA1[r] = 0.f; pB0[r] = 0.f; pB1[r] = 0.f; }
#pragma unroll
                      for (int d0 = 0; d0 < 6; ++d0) { pA0 = MFMA32(*(const LAS bf16x8*)(kp + d0 * 32), q[d0], pA0); pA1 = MFMA32(*(const LAS bf16x8*)(kp + 32 * ML_KSTRIDE + d0 * 32), q[d0], pA1); } }
                    int s0 = 0, s1 = 1, s2 = 2;
#define MLA_ROT() do { const int s_ = s0; s0 = s1; s1 = s2; s2 = s_; } while (0)
                    for (int t = 0; t < 62; t += 2) {
                        MLA_STORE(s2); if (t + 3 < 64) MLA_LOAD(t + 3);
                        dense_step<6, true>(q, lds + ML_K0 + s1 * ML_KB, ML_KSTRIDE, lds + ML_V0 + s0 * ML_VB, pA0, pA1, pB0, pB1, o, m, lacc, ones, MlaSpec::SC, wsf, lane);
                        __syncthreads(); MLA_ROT();
                        if (t + 3 < 64) { MLA_STORE(s2); } if (t + 4 < 64) MLA_LOAD(t + 4);
                        dense_step<6, true>(q, lds + ML_K0 + s1 * ML_KB, ML_KSTRIDE, lds + ML_V0 + s0 * ML_VB, pB0, pB1, pA0, pA1, o, m, lacc, ones, MlaSpec::SC, wsf, lane);
                        __syncthreads(); MLA_ROT();
                    }
                    dense_step<6, true>(q, lds + ML_K0 + s1 * ML_KB, ML_KSTRIDE, lds + ML_V0 + s0 * ML_VB, pA0, pA1, pB0, pB1, o, m, lacc, ones, MlaSpec::SC, wsf, lane);
                    __syncthreads(); MLA_ROT();
                    dense_step<6, false>(q, lds + ML_K0 + s1 * ML_KB, ML_KSTRIDE, lds + ML_V0 + s0 * ML_VB, pB0, pB1, pA0, pA1, o, m, lacc, ones, MlaSpec::SC, wsf, lane);
#undef MLA_LOAD
#undef MLA_STORE
#undef MLA_ROT
                    attn_finish_acc(o, lacc, sp, (LAS bf16_t*)(lds + ML_STG + wave * 4096), lane);
                }

#endif
                __syncthreads();
                LAS unsigned char* wl = lds + wave * AW_BYTES;
                const float* sink = ap->in[I_SINK] + jj * 8;

#if EN_SWA
                { const int vcu = (G % 8 == 0) ? (bid % 8) * (G / 8) + bid / 8 : bid, hq = wave;
                  const int PPW = (1024 + G - 1) / G, p1 = (vcu + 1) * PPW < 1024 ? (vcu + 1) * PPW : 1024;
                  for (int p = vcu * PPW; p < p1; ++p) {
                    const int qc = p & 127, b = p >> 7;
                    SwaSpec sp{big, mixed, b, hq, hq >> 2, 32 * qc, 32 * qc - 128};
                    attn_wave_item(sp, wl, lane, sink[hq] * LOG2E, 1.0f);
                  } }

#endif
            }
        } else if (st == 8) {
            pg8::Gemm g{mixed, (const bf16_t*)(ws + W_OUT), T, DM, DM, DM}; pg8::StaticOrder S; S.init(T, DM, G, bid);
            pg8::EpiResid E{(const float*)nullptr, hbf, DM, 1.0f};
            pg8::gemm_phase<pg8::EpiResid, pg8::StaticOrder>(lds, g, S, E, tid);
        }
#if PROBE_DUP
        { const bool isatt = (ph < DEPTH * 12) && ((even && st == 6) || (!even && st == 7));
          const bool ismisc = (ph < DEPTH * 12) && (st == 0 || st == 3 || st == 9 || (even && st == 7));
          const bool isup = (ph < DEPTH * 12) && (st == 1 || st == 10);
          if (!dup_done && ((PROBE_DUP == 1 && isatt) || (PROBE_DUP == 2 && ismisc) || (PROBE_DUP == 3 && isup))) { dup_done = true; --ph; } else dup_done = false; }
#endif
        if (ph + 1 < args.ph_hi) {
            if (ph == args.ph_lo) { __syncthreads(); grid.sync(); }
            else xcd_barrier(xbar);
            if (PROBE_DUP == 4) xcd_barrier(xbar);
        }
    }
}

extern "C" void kernel_launch(void* const* d_in, const int* in_sizes, int n_in, void* d_out, int out_size, void* d_ws, size_t ws_size, hipStream_t stream) {
    static int grid = 0;
    if (grid == 0) {
        if (n_in != 21 || ws_size < WS_END) { fprintf(stderr, "kernel_launch: unexpected inputs (n_in %d, ws %zu < %zu)\n", n_in, ws_size, (size_t)WS_END); grid = -1; return; }
        int dev = 0, cus = 0, per_cu = 0;
        hipGetDevice(&dev); hipDeviceGetAttribute(&cus, hipDeviceAttributeMultiprocessorCount, dev);
        if (hipFuncSetAttribute((const void*)fwd_megakernel, hipFuncAttributeMaxDynamicSharedMemorySize, LDS_BYTES) != hipSuccess) { fprintf(stderr, "kernel_launch: hipFuncSetAttribute failed\n"); grid = -1; return; }
        if (hipOccupancyMaxActiveBlocksPerMultiprocessor(&per_cu, (const void*)fwd_megakernel, NTHREADS, LDS_BYTES) != hipSuccess || per_cu < 1) { fprintf(stderr, "kernel_launch: occupancy query gave %d\n", per_cu); per_cu = 1; }
        (void)hipGetLastError();
        grid = cus * per_cu;
    }
    if (grid < 0) return;
    Args a{};
    for (int i = 0; i < 21; ++i) a.in[i] = (const float*)d_in[i];
    a.out = (float*)d_out; a.ws = (unsigned char*)d_ws;
    a.ph_lo = 0; a.ph_hi = DEPTH * 12 + 1;
    if (hipMemsetAsync((char*)d_ws + WS_BAR, 0, 16384, stream) != hipSuccess) { fprintf(stderr, "kernel_launch: memset failed\n"); return; }
    void* kargs[] = {&a};
    hipError_t e = hipLaunchCooperativeKernel((const void*)fwd_megakernel, dim3(grid), dim3(NTHREADS), kargs, LDS_BYTES, stream);
    if (e != hipSuccess) fprintf(stderr, "cooperative launch failed: %s (grid %d)\n", hipGetErrorString(e), grid);
}
```

```cpp
#include <hip/hip_runtime.h>
#include <hip/hip_cooperative_groups.h>
#include <cstdio>
#include <cstdint>
#include <cmath>
namespace cg = cooperative_groups;
#ifndef EN_DIL
#define EN_DIL 1
#endif
#ifndef EN_NA
#define EN_NA 1
#endif
#ifndef EN_MLA
#define EN_MLA 1
#endif
#ifndef EN_SWA
#define EN_SWA 1
#endif
#ifndef EN_GEMM
#define EN_GEMM 1
#endif
#ifndef EN_MISC
#define EN_MISC 1
#endif

#define LAS __attribute__((address_space(3)))
typedef unsigned short bf16_t;
typedef short bf16x8 __attribute__((ext_vector_type(8)));
typedef short s16x4 __attribute__((ext_vector_type(4)));
typedef float f32x4 __attribute__((ext_vector_type(4)));
typedef float f32x16 __attribute__((ext_vector_type(16)));
typedef unsigned u32x4 __attribute__((ext_vector_type(4)));
typedef unsigned u32x2 __attribute__((ext_vector_type(2)));

constexpr int T = 32768, DM = 1024, FF = 2816, SEQ = 4096, DEPTH = 4;
constexpr int EVEN_IN = 3072, ODD_IN = 1440, ODD_INP = 1536;
constexpr float NORM_EPS = 1e-6f;
constexpr float LOG2E = 1.4426950408889634f, LN2 = 0.6931471805599453f;
constexpr int NTHREADS = 512, NWAVES = 8;
constexpr int LDS_BYTES = 163840;

constexpr size_t MiB = 1u << 20;
constexpr size_t WS_COS = 0, WS_SIN = 512 * 1024;
constexpr size_t WS_W = 1 * MiB;
constexpr size_t W_UP1 = WS_W, W_DN1 = W_UP1 + (size_t)2 * FF * DM * 2, W_UP2 = W_DN1 + (size_t)DM * FF * 2, W_DN2 = W_UP2 + (size_t)2 * FF * DM * 2,
                 W_IN = W_DN2 + (size_t)DM * FF * 2, W_OUT = W_IN + (size_t)EVEN_IN * DM * 2, W_QB = W_OUT + (size_t)DM * DM * 2, W_KVB = W_QB + (size_t)768 * 384 * 2,
                 W_END = W_KVB + (size_t)1024 * 256 * 2;
static_assert(W_END <= 49 * MiB, "weights region");
constexpr size_t WS_HN = 49 * MiB;
constexpr size_t WS_BIG = WS_HN + 64 * MiB;
constexpr size_t WS_AUX = WS_BIG + 192 * MiB;
constexpr size_t AUX_LSE = 96 * MiB, AUX_KV = 48 * MiB;
constexpr size_t WS_NAO = WS_AUX + 116 * MiB;
constexpr size_t WS_BAR = WS_NAO + 64 * MiB;
constexpr size_t WS_END = WS_BAR + 16384;

__device__ __forceinline__ unsigned cvt_pk_bf16(float lo, float hi) { unsigned r; asm volatile("v_cvt_pk_bf16_f32 %0, %1, %2" : "=v"(r) : "v"(lo), "v"(hi)); return r; }
__device__ __forceinline__ float bf_lo(unsigned w) { return __uint_as_float(w << 16); }
__device__ __forceinline__ float bf_hi(unsigned w) { return __uint_as_float(w & 0xffff0000u); }
typedef _Float16 h16x2 __attribute__((ext_vector_type(2)));
__device__ __forceinline__ unsigned pk_f16(float lo, float hi) { const h16x2 v = (h16x2){(_Float16)lo, (_Float16)hi}; return __builtin_bit_cast(unsigned, v); }
__device__ __forceinline__ float f16_lo(unsigned w) { return (float)__builtin_bit_cast(h16x2, w)[0]; }
__device__ __forceinline__ float f16_hi(unsigned w) { return (float)__builtin_bit_cast(h16x2, w)[1]; }
template <int MASK> __device__ __forceinline__ float swz_xor(float v) { return __int_as_float(__builtin_amdgcn_ds_swizzle(__float_as_int(v), (MASK << 10) | 0x1f)); }
__device__ __forceinline__ float half_sum(float v) { auto rr = __builtin_amdgcn_permlane32_swap(__float_as_uint(v), __float_as_uint(v), false, false); return __uint_as_float(rr[0]) + __uint_as_float(rr[1]); }
__device__ __forceinline__ float half_max(float v) { auto rr = __builtin_amdgcn_permlane32_swap(__float_as_uint(v), __float_as_uint(v), false, false); return fmaxf(__uint_as_float(rr[0]), __uint_as_float(rr[1])); }
__device__ __forceinline__ float wave_sum(float v) {
    v += swz_xor<1>(v); v += swz_xor<2>(v); v += swz_xor<4>(v); v += swz_xor<8>(v); v += swz_xor<16>(v);
    return half_sum(v);
}
__device__ __forceinline__ float max3f(float a, float b, float c) { float r; asm("v_max3_f32 %0, %1, %2, %3" : "=v"(r) : "v"(a), "v"(b), "v"(c)); return r; }
__device__ __forceinline__ int crow(int r, int hi) { return (r & 3) + 8 * (r >> 2) + 4 * hi; }
__device__ __forceinline__ int clampi(int v, int lo, int hi) { return v < lo ? lo : (v > hi ? hi : v); }

namespace pg8 {
constexpr int BM = 256, BK = 64, HALF = 128, HTB = HALF * BK * 2  , STAGE_BYTES = 8 * HTB, NXCD = 8, WGM = 8;

__host__ __device__ __forceinline__ int lds_byte(int r, int c) { const int st = (r >> 4) * 2 + (c >> 5), rr = r & 15, cc = c & 31, ob = rr * 64 + cc * 2; return st * 1024 + (ob ^ (((ob >> 9) & 1) << 5)); }
__host__ __device__ __forceinline__ void stage_rc(int b, int& R, int& C) { const int st = b / 1024, sb = b % 1024, swz = sb ^ (((sb >> 9) & 1) << 5); R = (st >> 1) * 16 + swz / 64; C = (st & 1) * 32 + (swz % 64) / 2; }
__host__ __device__ __forceinline__ int perm32(int rho) { const int n = rho >> 4, i = rho & 15; return 8 * (i >> 2) + 4 * n + (i & 3); }

struct Unit { int pm, pn; };
struct Gemm { const bf16_t* A; const bf16_t* Bt; int M, N, K, lda; };

struct StaticOrder {
    int nM, nN, nwg, G, c;
    __host__ __device__ void init(int M, int N, int G_, int c_) { nM = M / BM; nN = N / BM; nwg = nM * nN; G = G_; c = c_; }
    __host__ __device__ bool next(int i, Unit& u) const {
        const long L = (long)i * G + c; if (L >= nwg) return false;
        int wgid = (int)L; { const int q = nwg / NXCD, r = nwg % NXCD, xcd = wgid % NXCD, off = wgid / NXCD; wgid = (xcd < r ? xcd * (q + 1) : r * (q + 1) + (xcd - r) * q) + off; }
        const int nig = WGM * nN, gid = wgid / nig, fm = gid * WGM, gsz = (nM - fm) < WGM ? (nM - fm) : WGM;
        u.pm = fm + ((wgid % nig) % gsz); u.pn = (wgid % nig) / gsz; return true;
    }
};


struct EpiBf16 {
    static constexpr bool PERM = true;
    bf16_t* O; int ldc;
    __device__ __forceinline__ void operator()(const f32x4 (&acc)[2][2][4][2], const Unit& u, int wr, int wc, int fr, int fq) const {
        const int row0 = u.pm * BM + wr * 64 + fr; const int col0 = u.pn * BM + wc * 32 + 8 * fq;
#pragma unroll
        for (int ai = 0; ai < 2; ++ai)
#pragma unroll
            for (int m = 0; m < 4; ++m) { bf16_t* rowp = O + (size_t)(row0 + ai * HALF + m * 16) * ldc + col0;
#pragma unroll
                for (int bj = 0; bj < 2; ++bj) { const f32x4 v0 = acc[ai][bj][m][0], v1 = acc[ai][bj][m][1];
                    u32x4 w; w.x = cvt_pk_bf16(v0[0], v0[1]); w.y = cvt_pk_bf16(v0[2], v0[3]); w.z = cvt_pk_bf16(v1[0], v1[1]); w.w = cvt_pk_bf16(v1[2], v1[3]);
                    *(u32x4*)(rowp + bj * HALF) = w; } }
    }
};
struct EpiSwiglu {
    static constexpr bool PERM = true;
    bf16_t* O; int ldc;
    __device__ __forceinline__ float sg(float a, float b) const { const float e = __builtin_amdgcn_exp2f(-a * LOG2E); return a * b * __builtin_amdgcn_rcpf(1.0f + e); }
    __device__ __forceinline__ void operator()(const f32x4 (&acc)[2][2][4][2], const Unit& u, int wr, int wc, int fr, int fq) const {
        const int row0 = u.pm * BM + wr * 64 + fr; const int col0 = u.pn * HALF + wc * 32 + 8 * fq;
#pragma unroll
        for (int ai = 0; ai < 2; ++ai)
#pragma unroll
            for (int m = 0; m < 4; ++m) { bf16_t* rowp = O + (size_t)(row0 + ai * HALF + m * 16) * ldc + col0;
                const f32x4 a0 = acc[ai][0][m][0], a1 = acc[ai][0][m][1], b0 = acc[ai][1][m][0], b1 = acc[ai][1][m][1];
                u32x4 w; w.x = cvt_pk_bf16(sg(a0[0], b0[0]), sg(a0[1], b0[1])); w.y = cvt_pk_bf16(sg(a0[2], b0[2]), sg(a0[3], b0[3]));
                w.z = cvt_pk_bf16(sg(a1[0], b1[0]), sg(a1[1], b1[1])); w.w = cvt_pk_bf16(sg(a1[2], b1[2]), sg(a1[3], b1[3]));
                *(u32x4*)rowp = w; }
    }
};
struct EpiResid {
    static constexpr bool PERM = false;
    const float* basef; bf16_t* h; int ldc; float scale;
    __device__ __forceinline__ void operator()(const f32x4 (&acc)[2][2][4][2], const Unit& u, int wr, int wc, int fr, int fq) const {
        const int col0 = u.pn * BM + wc * 32 + 4 * fq;
#pragma unroll
        for (int ai = 0; ai < 2; ++ai)
#pragma unroll
            for (int m = 0; m < 4; ++m) { const size_t off = (size_t)(u.pm * BM + ai * HALF + wr * 64 + m * 16 + fr) * ldc + col0;
#pragma unroll
                for (int bj = 0; bj < 2; ++bj)
#pragma unroll
                    for (int n = 0; n < 2; ++n) { f32x4 bs;
                        if (basef) bs = *(const f32x4*)(basef + off + bj * HALF + n * 16);
                        else { const u32x2 w = *(const u32x2*)(h + off + bj * HALF + n * 16); bs = (f32x4){f16_lo(w.x), f16_hi(w.x), f16_lo(w.y), f16_hi(w.y)}; }
                        const f32x4 o = bs + acc[ai][bj][m][n] * scale;
                        u32x2 wo; wo.x = pk_f16(o[0], o[1]); wo.y = pk_f16(o[2], o[3]); *(u32x2*)(h + off + bj * HALF + n * 16) = wo; }
                asm volatile("" ::: "memory"); }
    }
};

template <class Epi, class Sched>
__device__ __forceinline__ void gemm_phase(LAS unsigned char* lds, const Gemm g, const Sched& S, const Epi& E, const int tid) {
    const int wid = __builtin_amdgcn_readfirstlane(tid >> 6), lane = tid & 63, wr = wid >> 2, wc = wid & 3, fr = lane & 15, fq = lane >> 4;
    const int K = g.K, nt = K / BK, lda = g.lda;
    unsigned voffA[2], voffB[2];
#pragma unroll
    for (int i = 0; i < 2; ++i) { int R, C; stage_rc(tid * 16 + i * 8192, R, C); const int Rb = Epi::PERM ? ((R & ~31) + perm32(R & 31)) : R;
        voffA[i] = (unsigned)(R * lda + C) * 2u; voffB[i] = (unsigned)(Rb * K + C) * 2u; }
    const size_t kstep = (size_t)(BK * 2);
    const size_t hstepA = (size_t)HALF * lda * 2, hstepB = (size_t)HALF * K * 2;
    const size_t tstepA = 2 * hstepA, tstepB = 2 * hstepB;
    const unsigned ldsw = (unsigned)wid * 1024u;
    const int aoff = lds_byte(wr * 64 + fr, fq * 8), boff = lds_byte(wc * 32 + fr, fq * 8);
#define PG8_SA(b, h) (((b) * 2 + (h)) * HTB)
#define PG8_SB(b, h) ((4 + (b) * 2 + (h)) * HTB)
#define PG8_STAGE(bufoff, gbase, voff) do { _Pragma("unroll") for (int _i = 0; _i < 2; ++_i) \
        __builtin_amdgcn_global_load_lds((const unsigned*)((const char*)(gbase) + (voff)[_i]), (LAS unsigned*)(lds + (bufoff) + ldsw + _i * 8192), 16, 0, 0); } while (0)
#define PG8_LDA(dst, b, h) do { _Pragma("unroll") for (int m = 0; m < 4; ++m) _Pragma("unroll") for (int k = 0; k < 2; ++k) dst[m][k] = *(const LAS bf16x8*)(lds + PG8_SA(b, h) + aoff + m * 2048 + k * 1024); } while (0)
#define PG8_LDB(dst, b, h) do { _Pragma("unroll") for (int n = 0; n < 2; ++n) _Pragma("unroll") for (int k = 0; k < 2; ++k) dst[n][k] = *(const LAS bf16x8*)(lds + PG8_SB(b, h) + boff + n * 2048 + k * 1024); } while (0)
#define PG8_MMA(ai, bj, At, Bt) do { __builtin_amdgcn_s_setprio(1); _Pragma("unroll") for (int m = 0; m < 4; ++m) _Pragma("unroll") for (int n = 0; n < 2; ++n) _Pragma("unroll") for (int k = 0; k < 2; ++k) \
        acc[ai][bj][m][n] = __builtin_amdgcn_mfma_f32_16x16x32_bf16(Bt[n][k], At[m][k], acc[ai][bj][m][n], 0, 0, 0); __builtin_amdgcn_s_setprio(0); } while (0)
#define PG8_WAIT_V(n) asm volatile("s_waitcnt vmcnt(" #n ")" ::: "memory")
#define PG8_WAIT_L(n) asm volatile("s_waitcnt lgkmcnt(" #n ")" ::: "memory")
#define PG8_BAR __builtin_amdgcn_s_barrier()
#define PG8_SCHED __builtin_amdgcn_sched_barrier(0)
    Unit cur, nxt; int ui = 0;
    if (!S.next(0, cur)) return;
    f32x4 acc[2][2][4][2];
#pragma unroll
    for (int a = 0; a < 2; ++a)
#pragma unroll
        for (int b = 0; b < 2; ++b)
#pragma unroll
            for (int m = 0; m < 4; ++m)
#pragma unroll
                for (int n = 0; n < 2; ++n) acc[a][b][m][n] = (f32x4){0.f, 0.f, 0.f, 0.f};
    bf16x8 At[4][2], B0[2][2], B1[2][2];
    const char* cA = (const char*)g.A + (size_t)cur.pm * tstepA; const char* cB = (const char*)g.Bt + (size_t)cur.pn * tstepB;
    PG8_STAGE(PG8_SB(0, 0), cB, voffB); PG8_STAGE(PG8_SB(0, 1), cB + hstepB, voffB); PG8_STAGE(PG8_SA(0, 0), cA, voffA); PG8_STAGE(PG8_SA(0, 1), cA + hstepA, voffA);
    if (wr == 1) PG8_BAR;
    PG8_WAIT_V(2); PG8_BAR;
    PG8_STAGE(PG8_SB(1, 0), cB + kstep, voffB); PG8_STAGE(PG8_SA(1, 0), cA + kstep, voffA); PG8_STAGE(PG8_SB(1, 1), cB + hstepB + kstep, voffB);
    PG8_WAIT_V(6); PG8_BAR;
    for (;;) {
        const bool has_next = S.next(ui + 1, nxt);
        const char* nA = has_next ? (const char*)g.A + (size_t)nxt.pm * tstepA : cA; const char* nB = has_next ? (const char*)g.Bt + (size_t)nxt.pn * tstepB : cB;
        for (int t = 0; t < nt; t += 2) {
            const bool last = (t == nt - 2);
            const char* a1 = cA + (size_t)(t + 1) * kstep;
            const char* a2 = last ? nA : cA + (size_t)(t + 2) * kstep; const char* b2 = last ? nB : cB + (size_t)(t + 2) * kstep;
            const char* a3 = a2 + kstep; const char* b3 = b2 + kstep;
            PG8_LDB(B0, 0, 0); PG8_LDB(B1, 0, 1); PG8_SCHED; PG8_LDA(At, 0, 0); PG8_STAGE(PG8_SA(1, 1), a1 + hstepA, voffA);
            PG8_WAIT_V(8); PG8_WAIT_L(0); PG8_BAR; PG8_MMA(0, 0, At, B0); PG8_MMA(0, 1, At, B1); PG8_BAR; PG8_SCHED;
            PG8_LDA(At, 0, 1); PG8_STAGE(PG8_SB(0, 0), b2, voffB); PG8_STAGE(PG8_SB(0, 1), b2 + hstepB, voffB); PG8_STAGE(PG8_SA(0, 0), a2, voffA);
            PG8_WAIT_V(8); PG8_WAIT_L(0); PG8_BAR; PG8_MMA(1, 0, At, B0); PG8_MMA(1, 1, At, B1); PG8_BAR; PG8_SCHED;
            PG8_LDB(B0, 1, 0); PG8_LDB(B1, 1, 1); PG8_SCHED; PG8_LDA(At, 1, 0); PG8_STAGE(PG8_SA(0, 1), a2 + hstepA, voffA);
            PG8_WAIT_V(8); PG8_WAIT_L(0); PG8_BAR; PG8_MMA(0, 0, At, B0); PG8_MMA(0, 1, At, B1); PG8_BAR; PG8_SCHED;
            PG8_LDA(At, 1, 1); PG8_STAGE(PG8_SB(1, 0), b3, voffB); PG8_STAGE(PG8_SB(1, 1), b3 + hstepB, voffB); PG8_STAGE(PG8_SA(1, 0), a3, voffA);
            PG8_WAIT_V(8); PG8_WAIT_L(0); PG8_BAR; PG8_MMA(1, 0, At, B0); PG8_MMA(1, 1, At, B1); PG8_BAR; PG8_SCHED;
        }
        if (wr == 0) PG8_BAR;
        { int l2 = lane; asm volatile("" : "+v"(l2)); E(acc, cur, wr, wc, l2 & 15, l2 >> 4); }
        if (!has_next) break;
#pragma unroll
        for (int a = 0; a < 2; ++a)
#pragma unroll
            for (int b = 0; b < 2; ++b)
#pragma unroll
                for (int m = 0; m < 4; ++m)
#pragma unroll
                    for (int n = 0; n < 2; ++n) acc[a][b][m][n] = (f32x4){0.f, 0.f, 0.f, 0.f};
        cur = nxt; cA = nA; cB = nB; ++ui;
        if (wr == 1) PG8_BAR;
    }
    PG8_WAIT_V(0);
    PG8_BAR;
#undef PG8_SA
#undef PG8_SB
#undef PG8_STAGE
#undef PG8_LDA
#undef PG8_LDB
#undef PG8_MMA
#undef PG8_WAIT_V
#undef PG8_WAIT_L
#undef PG8_BAR
#undef PG8_SCHED
}
}

#define MFMA32(a, b, c) __builtin_amdgcn_mfma_f32_32x32x16_bf16(a, b, c, 0, 0, 0)
typedef short v4i16_t __attribute__((ext_vector_type(4)));
__device__ __forceinline__ s16x4 vtr(const LAS unsigned char* p) { return __builtin_bit_cast(s16x4, __builtin_amdgcn_ds_read_tr16_b64_v4i16((LAS v4i16_t*)p)); }

template <int ND, class Spec>
__device__ __forceinline__ void attn_scores(const bf16x8 (&q)[ND], const LAS unsigned char* kb, const int kstride,
                                            f32x16 (&o)[2], float& m, float& l, const Spec& sp, const int t, LAS float* wsf, const int lane, u32x4 (&pw)[4]) {
    const int r32 = lane & 31, hi = lane >> 5;
    f32x16 p0, p1;
    const f32x16 z16 = (f32x16){0.f, 0.f, 0.f, 0.f, 0.f, 0.f, 0.f, 0.f, 0.f, 0.f, 0.f, 0.f, 0.f, 0.f, 0.f, 0.f};
    const LAS unsigned char* kp = kb + r32 * kstride + hi * 16;
#pragma unroll
    for (int d0 = 0; d0 < ND; ++d0) {
        const bf16x8 k0 = *(const LAS bf16x8*)(kp + d0 * 32);
        const bf16x8 k1 = *(const LAS bf16x8*)(kp + 32 * kstride + d0 * 32);
        if (d0 == 0) { p0 = MFMA32(k0, q[d0], z16); p1 = MFMA32(k1, q[d0], z16); }
        else { p0 = MFMA32(k0, q[d0], p0); p1 = MFMA32(k1, q[d0], p1); }
    }
    { const auto cx = sp.prep(t, r32, hi);
#pragma unroll
      for (int r = 0; r < 16; ++r) { p0[r] = sp.mask(p0[r], cx, r, 0); p1[r] = sp.mask(p1[r], cx, r, 1); } }
    float rm = max3f(p0[0], p0[1], p1[0]), rb = max3f(p0[2], p0[3], p1[1]); rm = max3f(rm, p1[2], p1[3]);
#pragma unroll
    for (int r = 4; r < 16; r += 4) { rm = max3f(rm, p0[r], p0[r + 1]); rb = max3f(rb, p0[r + 2], p0[r + 3]); rm = max3f(rm, p1[r], p1[r + 1]); rb = max3f(rb, p1[r + 2], p1[r + 3]); }
    rm = half_max(fmaxf(rm, rb)) * Spec::SC;
    const float mnew = fmaxf(m, rm);
    if (__any(mnew > m)) {
        const float mref = (mnew == -INFINITY) ? 0.f : mnew;
        const float alpha = __builtin_amdgcn_exp2f(m - mref);
        l *= alpha; m = mnew;
        if (hi == 0) wsf[r32] = alpha;
#pragma unroll
        for (int r = 0; r < 16; ++r) { const float a = wsf[crow(r, hi)]; o[0][r] *= a; o[1][r] *= a; }
    }
    const float mref = (m == -INFINITY) ? 0.f : m;
    float ls = 0.f;
#pragma unroll
    for (int r = 0; r < 16; ++r) { p0[r] = __builtin_amdgcn_exp2f(__builtin_fmaf(p0[r], Spec::SC, -mref)); p1[r] = __builtin_amdgcn_exp2f(__builtin_fmaf(p1[r], Spec::SC, -mref)); ls += p0[r] + p1[r]; }
    l += ls;
#pragma unroll
    for (int j = 0; j < 4; ++j) { pw[0][j] = cvt_pk_bf16(p0[2 * j], p0[2 * j + 1]); pw[1][j] = cvt_pk_bf16(p0[8 + 2 * j], p0[8 + 2 * j + 1]);
                                  pw[2][j] = cvt_pk_bf16(p1[2 * j], p1[2 * j + 1]); pw[3][j] = cvt_pk_bf16(p1[8 + 2 * j], p1[8 + 2 * j + 1]); }
}
__device__ __forceinline__ void attn_pv(const u32x4 (&pw)[4], const LAS unsigned char* vb, f32x16 (&o)[2], const int lane, const int vhs = 4096) {
    const int hi = lane >> 5;
    const LAS unsigned char* vp = vb + ((lane >> 4) & 1) * 32 + (lane & 3) * 8 + (4 * hi + ((lane & 15) >> 2)) * 64;
    s16x4 lo[2][4], hh[2][4];
#pragma unroll
    for (int ks = 0; ks < 4; ++ks)
#pragma unroll
        for (int d0 = 0; d0 < 2; ++d0) { lo[d0][ks] = vtr(vp + d0 * vhs + ks * 1024); hh[d0][ks] = vtr(vp + d0 * vhs + ks * 1024 + 512); }
#pragma unroll
    for (int ks = 0; ks < 4; ++ks)
#pragma unroll
        for (int d0 = 0; d0 < 2; ++d0) {
            const bf16x8 vf = (bf16x8){lo[d0][ks][0], lo[d0][ks][1], lo[d0][ks][2], lo[d0][ks][3], hh[d0][ks][0], hh[d0][ks][1], hh[d0][ks][2], hh[d0][ks][3]};
            o[d0] = MFMA32(__builtin_bit_cast(bf16x8, pw[ks]), vf, o[d0]);
        }
}

#define PIN16(x) asm volatile("" : "+v"(x))
template <int ND, bool HAS_NEXT>
__device__ __forceinline__ void dense_step(const bf16x8 (&q)[ND], const LAS unsigned char* kbn, const int kstride, const LAS unsigned char* vb,
                                           f32x16& PA0, f32x16& PA1, f32x16& PB0, f32x16& PB1, f32x16 (&o)[2], float& m, float& l, const float SC, LAS float* wsf, const int lane) {
    const int r32 = lane & 31, hi = lane >> 5;
    float rm = max3f(PA0[0], PA0[1], PA1[0]), rb = max3f(PA0[2], PA0[3], PA1[1]); rm = max3f(rm, PA1[2], PA1[3]);
#pragma unroll
    for (int r = 4; r < 16; r += 4) { rm = max3f(rm, PA0[r], PA0[r + 1]); rb = max3f(rb, PA0[r + 2], PA0[r + 3]); rm = max3f(rm, PA1[r], PA1[r + 1]); rb = max3f(rb, PA1[r + 2], PA1[r + 3]); }
    rm = half_max(fmaxf(rm, rb)) * SC;
    const float mnew = fmaxf(m, rm);
    if (__any(mnew > m)) {
        const float alpha = __builtin_amdgcn_exp2f(m - mnew);
        l *= alpha; m = mnew;
        if (hi == 0) wsf[r32] = alpha;
#pragma unroll
        for (int r = 0; r < 16; ++r) { const float a = wsf[crow(r, hi)]; o[0][r] *= a; o[1][r] *= a; }
    }
    const float nm = -m;
    __builtin_amdgcn_sched_barrier(0);
    const LAS unsigned char* kp = kbn + r32 * kstride + hi * 16;
    float ls = 0.f;
    constexpr int NM = 2 * ND;
    const f32x16 z16 = (f32x16){0.f, 0.f, 0.f, 0.f, 0.f, 0.f, 0.f, 0.f, 0.f, 0.f, 0.f, 0.f, 0.f, 0.f, 0.f, 0.f};
    bf16x8 kfr[3] = {q[0], q[0], q[0]};
    if constexpr (HAS_NEXT) {
#pragma unroll
        for (int i = 0; i < 3; ++i) kfr[i] = *(const LAS bf16x8*)(kp + (i & 1) * 32 * kstride + (i >> 1) * 32);
    }
#pragma unroll
    for (int i = 0; i < NM; ++i) {
        if constexpr (HAS_NEXT) {
            const int d0 = i >> 1;
            const bf16x8 kf = kfr[i % 3];
            if (i & 1) PB1 = (d0 == 0) ? MFMA32(kf, q[d0], z16) : MFMA32(kf, q[d0], PB1);
            else       PB0 = (d0 == 0) ? MFMA32(kf, q[d0], z16) : MFMA32(kf, q[d0], PB0);
            if (i + 3 < NM) kfr[i % 3] = *(const LAS bf16x8*)(kp + ((i + 3) & 1) * 32 * kstride + ((i + 3) >> 1) * 32);
        }
#pragma unroll
        for (int e = (32 * i) / NM; e < (32 * (i + 1)) / NM; ++e) {
            if (e < 16) { PA0[e] = __builtin_amdgcn_exp2f(__builtin_fmaf(PA0[e], SC, nm)); ls += PA0[e]; }
            else { PA1[e - 16] = __builtin_amdgcn_exp2f(__builtin_fmaf(PA1[e - 16], SC, nm)); ls += PA1[e - 16]; }
        }
        PIN16(PA0); PIN16(PA1); PIN16(ls);
        __builtin_amdgcn_sched_barrier(0);
    }
    l += ls;
    u32x4 pw[4];
#pragma unroll
    for (int j = 0; j < 4; ++j) { pw[0][j] = cvt_pk_bf16(PA0[2 * j], PA0[2 * j + 1]); pw[1][j] = cvt_pk_bf16(PA0[8 + 2 * j], PA0[8 + 2 * j + 1]);
                                  pw[2][j] = cvt_pk_bf16(PA1[2 * j], PA1[2 * j + 1]); pw[3][j] = cvt_pk_bf16(PA1[8 + 2 * j], PA1[8 + 2 * j + 1]); }
    attn_pv(pw, vb, o, lane);
}

template <class Spec>
__device__ __forceinline__ float attn_finish(f32x16 (&o)[2], const float l, const Spec& sp, LAS float* wsf, LAS bf16_t* stg, const int lane) {
    const int r32 = lane & 31, hi = lane >> 5;
    const float lt = half_sum(l);
    if (hi == 0) wsf[32 + r32] = lt;
#pragma unroll
    for (int r = 0; r < 16; ++r) { const int orow = crow(r, hi); const float rl = 1.0f / wsf[32 + orow];
        const unsigned w = cvt_pk_bf16(o[0][r] * rl, o[1][r] * rl);
        stg[orow * 64 + r32] = (bf16_t)(w & 0xffffu); stg[orow * 64 + 32 + r32] = (bf16_t)(w >> 16); }
#pragma unroll
    for (int i = 0; i < 4; ++i) { const int row = i * 8 + (lane >> 3), ch = lane & 7; *(u32x4*)(sp.orow(row) + ch * 8) = *(const LAS u32x4*)(stg + row * 64 + ch * 8); }
    return lt;
}

constexpr int AW_K = 0, AW_KSTRIDE = 144, AW_V = 9216, AW_WSF = 17408, AW_BIAS = 17664, AW_BYTES = 19712;
static_assert(AW_BYTES * NWAVES <= LDS_BYTES, "attention LDS");

template <class Spec>
__device__ __forceinline__ void attn_wave_item(const Spec& sp, LAS unsigned char* wl, const int lane, float m0, float l0) {
    const int r32 = lane & 31, hi = lane >> 5;
    LAS float* wsf = (LAS float*)(wl + AW_WSF);
    bf16x8 q[4];
    { const bf16_t* qp = sp.qrow(r32);
#pragma unroll
      for (int d0 = 0; d0 < 4; ++d0) q[d0] = *(const bf16x8*)(qp + d0 * 16 + hi * 8); }
    f32x16 o[2];
#pragma unroll
    for (int r = 0; r < 16; ++r) { o[0][r] = 0.f; o[1][r] = 0.f; }
    float m = m0, l = (hi == 0) ? l0 : 0.f;
    int tlo = 0, thi = Spec::NT;
    while (tlo < thi && sp.skip(tlo)) ++tlo;
    while (thi > tlo && sp.skip(thi - 1)) --thi;
    const int lrow = lane >> 3, lc = lane & 7;
    u32x4 kr[8];
#pragma unroll
    for (int j = 0; j < 8; ++j) kr[j] = *(const u32x4*)(sp.kptr(sp.ktok(tlo, j * 8 + lrow)) + lc * 8);
    LAS unsigned char* kw = wl + AW_K + lrow * AW_KSTRIDE + lc * 16; LAS unsigned char* vw = wl + AW_V + (lc >> 2) * 4096 + lrow * 64 + (lc & 3) * 16;
    for (int t = tlo; t < thi; ++t) {
#pragma unroll
        for (int j = 0; j < 8; ++j) *(LAS u32x4*)(kw + j * 8 * AW_KSTRIDE) = kr[j];
#pragma unroll
        for (int j = 0; j < 8; ++j) kr[j] = *(const u32x4*)(sp.vptr(sp.ktok(t, j * 8 + lrow)) + lc * 8);
        u32x4 pw[4];
        attn_scores<4, Spec>(q, wl + AW_K, AW_KSTRIDE, o, m, l, sp, t, wsf, lane, pw);
#pragma unroll
        for (int j = 0; j < 8; ++j) *(LAS u32x4*)(vw + j * 8 * 64) = kr[j];
        if (t + 1 < thi) {
#pragma unroll
            for (int j = 0; j < 8; ++j) kr[j] = *(const u32x4*)(sp.kptr(sp.ktok(t + 1, j * 8 + lrow)) + lc * 8);
        }
        attn_pv(pw, wl + AW_V, o, lane);
    }
    const float lt = attn_finish(o, l, sp, wsf, (LAS bf16_t*)(wl + AW_K), lane);
    sp.finish(m, lt, r32, hi);
}

struct DilSpec {
    static constexpr int NT = 3;
    const bf16_t* proj; const bf16_t* kc; bf16_t* oc; float* lse; int b, r, d, sd, ci0, h, kstart;
    __device__ __forceinline__ const bf16_t* qrow(int row) const { return proj + (size_t)(b * SEQ + (ci0 + row) * d + r) * EVEN_IN + h * 64; }
    __device__ __forceinline__ bool skip(int t) const { const int k0 = kstart + 64 * t; return (k0 + 63 < 0) || (k0 >= sd); }
    __device__ __forceinline__ size_t ktok(int t, int kk) const { const int kj = clampi(kstart + 64 * t + kk, 0, sd - 1), tk = kj * d + r; return (size_t)(b * SEQ + ((tk & 15) << 8) + (tk >> 4)); }
    __device__ __forceinline__ const bf16_t* kptr(size_t row) const { return kc + row * 1024 + h * 64; }
    __device__ __forceinline__ const bf16_t* vptr(size_t row) const { return kc + row * 1024 + 512 + h * 64; }
    static constexpr float SC = 0.125f * LOG2E;
    struct Cx { int a; unsigned w; };
    __device__ __forceinline__ Cx prep(int t, int r32, int hi) const { const int qi = ci0 + r32, lo = qi - 64 > 0 ? qi - 64 : 0, hi_ = qi + 64 < sd - 1 ? qi + 64 : sd - 1; return Cx{kstart + 64 * t + 4 * hi - lo, (unsigned)(hi_ - lo)}; }
    __device__ __forceinline__ float mask(float s, const Cx& cx, int r, int half) const { return ((unsigned)(cx.a + ((r & 3) + 8 * (r >> 2) + 32 * half)) <= cx.w) ? s : -INFINITY; }
    __device__ __forceinline__ bf16_t* orow(int row) const { return oc + (size_t)(b * SEQ + (ci0 + row) * d + r) * 512 + h * 64; }
    __device__ __forceinline__ void finish(float m, float lt, int r32, int hi) const { if (hi == 0) lse[(size_t)(b * SEQ + (ci0 + r32) * d + r) * 8 + h] = m * LN2 + __logf(lt); }
};
struct NaSpec {
    static constexpr int NT = 5;
    const bf16_t* proj; bf16_t* mixed; const LAS float* bias; int b, gr, hf, h, rs, cb;
    __device__ __forceinline__ const bf16_t* qrow(int row) const { return proj + (size_t)(b * SEQ + gr * 64 + 32 * hf + row) * EVEN_IN + 1536 + h * 64; }
    __device__ __forceinline__ bool skip(int) const { return false; }
    __device__ __forceinline__ size_t ktok(int t, int kk) const { return (size_t)(b * SEQ + (rs + (kk >> 3)) * 64 + cb + 8 * t + (kk & 7)); }
    __device__ __forceinline__ const bf16_t* kptr(size_t tok) const { return proj + tok * EVEN_IN + 2048 + h * 64; }
    __device__ __forceinline__ const bf16_t* vptr(size_t tok) const { return proj + tok * EVEN_IN + 2560 + h * 64; }
    static constexpr float SC = 0.125f * LOG2E;
    struct Cx { const LAS float* bp[4]; bool v[4]; };
    __device__ __forceinline__ Cx prep(int t, int r32, int hi) const { Cx c; const int qcol = 32 * hf + r32, ws = clampi(qcol - 8, 0, 48);
#pragma unroll
        for (int j = 0; j < 4; ++j) { const int kcol = cb + 8 * t + j + 4 * hi; c.v[j] = (kcol >= ws) && (kcol < ws + 16); c.bp[j] = bias + (rs - gr + 7) * 31 + clampi(kcol - qcol + 15, 0, 30); }
        return c; }
    __device__ __forceinline__ float mask(float s, const Cx& cx, int r, int half) const { return cx.v[r & 3] ? s + cx.bp[r & 3][31 * ((r >> 2) + 4 * half)] : -INFINITY; }
    __device__ __forceinline__ bf16_t* orow(int row) const { return mixed + (size_t)(b * SEQ + gr * 64 + 32 * hf + row) * DM + 512 + h * 64; }
    __device__ __forceinline__ void finish(float, float, int, int) const {}
};
struct SwaSpec {
    static constexpr int NT = 5;
    const bf16_t* proj; bf16_t* mixed; int b, hq, kvh, q0, kstart;
    __device__ __forceinline__ const bf16_t* qrow(int row) const { return proj + (size_t)(b * SEQ + q0 + row) * ODD_INP + hq * 64; }
    __device__ __forceinline__ bool skip(int t) const { const int k0 = kstart + 64 * t; return (k0 + 63 < 0) || (k0 >= SEQ); }
    __device__ __forceinline__ size_t ktok(int t, int kk) const { return (size_t)(b * SEQ + clampi(kstart + 64 * t + kk, 0, SEQ - 1)); }
    __device__ __forceinline__ const bf16_t* kptr(size_t tok) const { return proj + tok * ODD_INP + 512 + kvh * 64; }
    __device__ __forceinline__ const bf16_t* vptr(size_t tok) const { return proj + tok * ODD_INP + 640 + kvh * 64; }
    static constexpr float SC = 0.125f * LOG2E;
    struct Cx { int a; unsigned w; };
    __device__ __forceinline__ Cx prep(int t, int r32, int hi) const { const int qi = q0 + r32, lo = qi - 128 > 0 ? qi - 128 : 0, hi_ = qi + 128 < SEQ - 1 ? qi + 128 : SEQ - 1; return Cx{kstart + 64 * t + 4 * hi - lo, (unsigned)(hi_ - lo)}; }
    __device__ __forceinline__ float mask(float s, const Cx& cx, int r, int half) const { return ((unsigned)(cx.a + ((r & 3) + 8 * (r >> 2) + 32 * half)) <= cx.w) ? s : -INFINITY; }
    __device__ __forceinline__ bf16_t* orow(int row) const { return mixed + (size_t)(b * SEQ + q0 + row) * DM + hq * 64; }
    __device__ __forceinline__ void finish(float, float, int, int) const {}
};
struct MlaSpec {
    static constexpr float SC = 0.10206207261596577f * LOG2E;
    bf16_t* mixed; int tok0, h;
    __device__ __forceinline__ bf16_t* orow(int row) const { return mixed + (size_t)(tok0 + row) * DM + 512 + h * 64; }
};
constexpr int ML_K0 = 0, ML_KSTRIDE = 208, ML_KB = 13312, ML_V0 = 3 * ML_KB, ML_VB = 8192, ML_WSF = ML_V0 + 3 * ML_VB,
              ML_STG = ML_WSF + NWAVES * 256, ML_BYTES = ML_STG + NWAVES * 4096;
static_assert(ML_BYTES <= LDS_BYTES, "mla LDS");

#define XB_TMO      128
#define XB_XCNT(j)  (256  + 64 * (j))
#define XB_XSUB(j)  (1280 + 64 * (j))
#define XB_XGEN(j)  (2304 + 64 * (j))
#define XB_TOP      3328
#define XB_TOPGEN   3392
#define XCD_BAR_WORDS 3456
#define XB_SPIN_CAP (1u << 18)

__device__ __forceinline__ unsigned xb_ld(unsigned* p)              { return __hip_atomic_load(p, __ATOMIC_RELAXED, __HIP_MEMORY_SCOPE_AGENT); }
__device__ __forceinline__ unsigned xb_add(unsigned* p, unsigned v) { return __hip_atomic_fetch_add(p, v, __ATOMIC_RELAXED, __HIP_MEMORY_SCOPE_AGENT); }
__device__ __forceinline__ unsigned xb_xcc_id() { return (unsigned)__builtin_amdgcn_s_getreg((3 << 11) | 20) & 0xFu; }
#define XB_SPIN(cond, bar) do { unsigned _sp = 0; while (cond) { __builtin_amdgcn_s_sleep(1); \
    if ((++_sp & 255u) == 0u) { if (xb_ld(&(bar)[XB_TMO])) break; if (_sp > XB_SPIN_CAP) { atomicAdd(&(bar)[XB_TMO], 1u); break; } } } } while (0)

struct XcdBarrier {
    unsigned* bar; unsigned x;
    volatile LAS unsigned* st;
};

__device__ __forceinline__ XcdBarrier xcd_barrier_post(unsigned* bar, volatile LAS unsigned* st) {
    XcdBarrier b; b.bar = bar; b.x = xb_xcc_id(); b.st = st;
    if (threadIdx.x == 0) (void)xb_add(&bar[XB_XCNT(b.x)], 1u);
    return b;
}
__device__ __forceinline__ void xcd_barrier_complete(unsigned* bar, unsigned x, unsigned& nloc, unsigned& nx) {
    const unsigned G = gridDim.x * gridDim.y * gridDim.z;
    unsigned sum, cnt, mine, sp = 0u;
    for (;;) {
        sum = 0u; cnt = 0u; mine = 0u;
#pragma unroll
        for (unsigned j = 0; j < 16; ++j) { const unsigned c = xb_ld(&bar[XB_XCNT(j)]); sum += c; cnt += (c > 0u) ? 1u : 0u; mine = (j == x) ? c : mine; }
        if (sum == G) break;
        __builtin_amdgcn_s_sleep(1);
        if ((++sp & 255u) == 0u) { if (xb_ld(&bar[XB_TMO])) break; if (sp > XB_SPIN_CAP) { atomicAdd(&bar[XB_TMO], 1u); break; } }
    }
    nloc = mine > 0u ? mine : 1u; nx = cnt > 0u ? cnt : 1u;
}

__device__ __forceinline__ void xcd_barrier(const XcdBarrier& b) {
    asm volatile("s_waitcnt vmcnt(0)" ::: "memory");
    __syncthreads();
    if (threadIdx.x == 0) {
        unsigned* bar = b.bar;
        __builtin_amdgcn_s_waitcnt(0);
        unsigned nloc = b.st[0], nx = b.st[1];
        if (nloc == 0u) { xcd_barrier_complete(bar, b.x, nloc, nx); b.st[0] = nloc; b.st[1] = nx; }
        const unsigned old = xb_add(&bar[XB_XSUB(b.x)], 1u);
        const unsigned gen = old / nloc;
        if (old + 1u == (gen + 1u) * nloc) {
            __builtin_amdgcn_fence(__ATOMIC_RELEASE, "agent");
            asm volatile("s_waitcnt vmcnt(0)" ::: "memory");
            const unsigned og = xb_add(&bar[XB_TOP], 1u);
            const unsigned tg = og / nx;
            if (og + 1u == (tg + 1u) * nx) xb_add(&bar[XB_TOPGEN], 1u);
            else XB_SPIN(xb_ld(&bar[XB_TOPGEN]) == tg, bar);
            __builtin_amdgcn_fence(__ATOMIC_ACQUIRE, "agent");
            asm volatile("s_waitcnt vmcnt(0)" ::: "memory");
        } else {
            __builtin_amdgcn_fence(__ATOMIC_ACQUIRE, "agent");
            XB_SPIN(xb_ld(&bar[XB_TOPGEN]) == gen, bar);
            asm volatile("s_waitcnt vmcnt(0)" ::: "memory");
        }
    }
    __syncthreads();
}

struct Args {
    const float* in[21];
    float* out; unsigned char* ws;
    int ph_lo, ph_hi;
};
typedef const __attribute__((address_space(4))) Args CArgs;
enum { I_X = 0, I_F1N, I_F1W1, I_F1W3, I_F1W2, I_MIXN, I_F2N, I_F2W1, I_F2W3, I_F2W2, I_EWIN, I_EWOUT, I_RPB, I_OWIN, I_OWOUT, I_SINK, I_QN, I_WQB, I_KVN, I_WKVB, I_FN };

__device__ __forceinline__ void rmsnorm_rows(const float* h, const float* g, bf16_t* hn, int gw, int NGW, int lane) {
    f32x4 gv[4];
#pragma unroll
    for (int j = 0; j < 4; ++j) gv[j] = ((const f32x4*)g)[lane + 64 * j];
    for (int row = gw; row < T; row += NGW) {
        const f32x4* xr = (const f32x4*)(h + (size_t)row * DM) + lane;
        f32x4 v[4]; float s = 0.f;
#pragma unroll
        for (int j = 0; j < 4; ++j) { v[j] = xr[64 * j]; s += (v[j].x * v[j].x + v[j].y * v[j].y) + (v[j].z * v[j].z + v[j].w * v[j].w); }
        const float rstd = 1.0f / sqrtf(wave_sum(s) * (1.0f / DM) + NORM_EPS);
        u32x2* o8 = (u32x2*)(hn + (size_t)row * DM) + lane;
#pragma unroll
        for (int j = 0; j < 4; ++j) { const f32x4 y = v[j] * rstd * gv[j]; u32x2 w; w.x = cvt_pk_bf16(y.x, y.y); w.y = cvt_pk_bf16(y.z, y.w); o8[64 * j] = w; }
    }
}
__device__ __forceinline__ void load_row_bf16(const bf16_t* hrow, int lane, float (&x)[16]) {
    const u32x4 a = ((const u32x4*)hrow)[lane], b = ((const u32x4*)hrow)[64 + lane];
#pragma unroll
    for (int j = 0; j < 4; ++j) { x[2 * j] = f16_lo(a[j]); x[2 * j + 1] = f16_hi(a[j]); x[8 + 2 * j] = f16_lo(b[j]); x[8 + 2 * j + 1] = f16_hi(b[j]); }
}
__device__ __forceinline__ void rmsnorm_rows_bf16(const bf16_t* h, const float* g, bf16_t* hn, int gw, int NGW, int lane) {
    float gv[16];
#pragma unroll
    for (int j = 0; j < 8; ++j) { gv[j] = g[lane * 8 + j]; gv[8 + j] = g[512 + lane * 8 + j]; }
    for (int row = gw; row < T; row += NGW) {
        float x[16]; load_row_bf16(h + (size_t)row * DM, lane, x);
        float s = 0.f;
#pragma unroll
        for (int j = 0; j < 16; ++j) s += x[j] * x[j];
        const float rstd = 1.0f / sqrtf(wave_sum(s) * (1.0f / DM) + NORM_EPS);
        u32x4 a, b;
#pragma unroll
        for (int j = 0; j < 4; ++j) { a[j] = cvt_pk_bf16(x[2 * j] * rstd * gv[2 * j], x[2 * j + 1] * rstd * gv[2 * j + 1]); b[j] = cvt_pk_bf16(x[8 + 2 * j] * rstd * gv[8 + 2 * j], x[8 + 2 * j + 1] * rstd * gv[8 + 2 * j + 1]); }
        ((u32x4*)(hn + (size_t)row * DM))[lane] = a; ((u32x4*)(hn + (size_t)row * DM))[64 + lane] = b;
    }
}
__device__ __forceinline__ void final_norm_rows(const bf16_t* h, float* out, const float* g, int gw, int NGW, int lane) {
    float gv[16];
#pragma unroll
    for (int j = 0; j < 8; ++j) { gv[j] = g[lane * 8 + j]; gv[8 + j] = g[512 + lane * 8 + j]; }
    for (int row = gw; row < T; row += NGW) {
        float x[16]; load_row_bf16(h + (size_t)row * DM, lane, x);
        float s = 0.f;
#pragma unroll
        for (int j = 0; j < 16; ++j) s += x[j] * x[j];
        const float rstd = 1.0f / sqrtf(wave_sum(s) * (1.0f / DM) + NORM_EPS);
        float* orow = out + (size_t)row * DM;
#pragma unroll
        for (int j = 0; j < 2; ++j) {
            *(f32x4*)(orow + lane * 8 + 4 * j) = (f32x4){x[4 * j] * rstd * gv[4 * j], x[4 * j + 1] * rstd * gv[4 * j + 1], x[4 * j + 2] * rstd * gv[4 * j + 2], x[4 * j + 3] * rstd * gv[4 * j + 3]};
            *(f32x4*)(orow + 512 + lane * 8 + 4 * j) = (f32x4){x[8 + 4 * j] * rstd * gv[8 + 4 * j], x[8 + 4 * j + 1] * rstd * gv[8 + 4 * j + 1], x[8 + 4 * j + 2] * rstd * gv[8 + 4 * j + 2], x[8 + 4 * j + 3] * rstd * gv[8 + 4 * j + 3]}; }
    }
}
__device__ __forceinline__ void transpose_item(const float* W, int srcN, int k0, int sc0, bf16_t* WT, int K, int dr0, LAS float* scr, int lane) {
#pragma unroll 8
    for (int i = 0; i < 32; ++i) { const int kk = 2 * i + (lane >> 5); scr[kk * 33 + (lane & 31)] = W[(size_t)(k0 + kk) * srcN + sc0 + (lane & 31)]; }
    asm volatile("s_waitcnt lgkmcnt(0)" ::: "memory");
    const int c = lane & 7;
#pragma unroll
    for (int j = 0; j < 4; ++j) { const int n = (lane >> 3) + 8 * j; const LAS float* s = scr + (8 * c) * 33 + n;
        u32x4 o; o.x = cvt_pk_bf16(s[0 * 33], s[1 * 33]); o.y = cvt_pk_bf16(s[2 * 33], s[3 * 33]); o.z = cvt_pk_bf16(s[4 * 33], s[5 * 33]); o.w = cvt_pk_bf16(s[6 * 33], s[7 * 33]);
        *(u32x4*)(WT + (size_t)(dr0 + n) * K + k0 + 8 * c) = o; }
    asm volatile("s_waitcnt lgkmcnt(0)" ::: "memory");
}
__device__ __forceinline__ void tr_plain(const float* W, int K, int N, bf16_t* WT, int item, LAS float* scr, int lane) {
    const int nblk = N / 32, kb = item / nblk, nb = item % nblk;
    transpose_item(W, N, 64 * kb, 32 * nb, WT, K, 32 * nb, scr, lane);
}
__device__ __forceinline__ void tr_up(const float* w1, const float* w3, bf16_t* WT, int item, LAS float* scr, int lane) {
    constexpr int nrb = 2 * FF / 32; const int kb = item / nrb, rb = item % nrb, pn = rb >> 3, within = rb & 7, half = within >> 2, sub = within & 3;
    transpose_item(half ? w3 : w1, FF, 64 * kb, pn * 128 + sub * 32, WT, DM, 32 * rb, scr, lane);
}

__device__ __forceinline__ void sincos_d(double a, double& s, double& c) {
    const double k = rint(a * 0.63661977236758134308);
    double r = fma(-k, 1.57079632679489655800e+00, a); r = fma(-k, 6.12323399573676603587e-17, r);
    const double r2 = r * r;
    double sp = 1.0 / 6227020800.0; sp = fma(sp, r2, -1.0 / 39916800.0); sp = fma(sp, r2, 1.0 / 362880.0); sp = fma(sp, r2, -1.0 / 5040.0); sp = fma(sp, r2, 1.0 / 120.0); sp = fma(sp, r2, -1.0 / 6.0);
    const double sr = fma(sp * r2, r, r);
    double cp = -1.0 / 87178291200.0; cp = fma(cp, r2, 1.0 / 479001600.0); cp = fma(cp, r2, -1.0 / 3628800.0); cp = fma(cp, r2, 1.0 / 40320.0); cp = fma(cp, r2, -1.0 / 720.0); cp = fma(cp, r2, 1.0 / 24.0); cp = fma(cp, r2, -0.5);
    const double cr = fma(cp, r2, 1.0);
    const int qd = ((int)k) & 3;
    s = (qd == 0) ? sr : (qd == 1) ? cr : (qd == 2) ? -sr : -cr;
    c = (qd == 0) ? cr : (qd == 1) ? -sr : (qd == 2) ? -cr : sr;
}

__device__ __forceinline__ void rope8(u32x4& a, u32x4& b, const float* cs, const float* sn, int st) {
    u32x4 ra, rb;
#pragma unroll
    for (int j = 0; j < 4; ++j) {
        const float x1l = bf_lo(a[j]), x1h = bf_hi(a[j]), x2l = bf_lo(b[j]), x2h = bf_hi(b[j]);
        const float cl = cs[(2 * j) * st], ch = cs[(2 * j + 1) * st], sl = sn[(2 * j) * st], sh = sn[(2 * j + 1) * st];
        ra[j] = cvt_pk_bf16(x1l * cl - x2l * sl, x1h * ch - x2h * sh);
        rb[j] = cvt_pk_bf16(x2l * cl + x1l * sl, x2h * ch + x1h * sh);
    }
    a = ra; b = rb;
}

__device__ __forceinline__ void rope8_fly(u32x4& a, u32x4& b, const float pos, const int i0) {
    u32x4 ra, rb;
#pragma unroll
    for (int j = 0; j < 4; ++j) {
        float cs[2], sn[2];
#pragma unroll
        for (int e = 0; e < 2; ++e) { const float rev = __builtin_amdgcn_fractf(pos * (__builtin_amdgcn_exp2f((float)(i0 + 2 * j + e) * (-13.287712379549449f / 32.0f)) * 0.15915494309189535f));
            sn[e] = __builtin_amdgcn_sinf(rev); cs[e] = __builtin_amdgcn_cosf(rev); }
        const float x1l = bf_lo(a[j]), x1h = bf_hi(a[j]), x2l = bf_lo(b[j]), x2h = bf_hi(b[j]);
        ra[j] = cvt_pk_bf16(x1l * cs[0] - x2l * sn[0], x1h * cs[1] - x2h * sn[1]);
        rb[j] = cvt_pk_bf16(x2l * cs[0] + x1l * sn[0], x2h * cs[1] + x1h * sn[1]);
    }
    a = ra; b = rb;
}

__global__ void __launch_bounds__(NTHREADS, 2) fwd_megakernel(Args args) {
    extern __shared__ __attribute__((aligned(16))) unsigned char lds_raw[];
    LAS unsigned char* lds = (LAS unsigned char*)lds_raw;
    cg::grid_group grid = cg::this_grid();
    const int G = gridDim.x, NGW = G * NWAVES;
    unsigned char* ws0 = args.ws;
    volatile LAS unsigned* bst = (volatile LAS unsigned*)(lds + LDS_BYTES - 64);
    if (threadIdx.x < 16) bst[threadIdx.x] = 0u;
    __syncthreads();
    const XcdBarrier xbar = xcd_barrier_post((unsigned*)(ws0 + WS_BAR), bst);

    if (args.ph_lo == 0) {
        float* cosT = (float*)(ws0 + WS_COS); float* sinT = (float*)(ws0 + WS_SIN);
        for (int e = blockIdx.x * NTHREADS + threadIdx.x; e < SEQ * 32; e += G * NTHREADS) {
            const int pos = e >> 5, i = e & 31; double s, c; sincos_d((double)pos * exp2((double)i * (-13.287712379549449 / 32.0)), s, c); cosT[e] = (float)c; sinT[e] = (float)s; }
    }
#ifndef PROBE_DUP
#define PROBE_DUP 0
#endif
    bool dup_done = false; (void)dup_done;
    for (int ph = args.ph_lo; ph < args.ph_hi; ++ph) {
        int tid = threadIdx.x; asm volatile("" : "+v"(tid));
        int bid = blockIdx.x; asm volatile("" : "+s"(bid));
        const CArgs* ap = (const CArgs*)__builtin_amdgcn_kernarg_segment_ptr(); asm volatile("" : "+s"(ap));
        const int lane = tid & 63, wave = __builtin_amdgcn_readfirstlane(tid >> 6), gw = bid * NWAVES + wave;
        unsigned char* ws = ap->ws; float* hres = ap->out;
        float* cosT = (float*)(ws + WS_COS); float* sinT = (float*)(ws + WS_SIN);
        bf16_t* hn = (bf16_t*)(ws + WS_HN); bf16_t* mixed = hn;
        bf16_t* hbf = (bf16_t*)(ws + WS_NAO);
        bf16_t* big = (bf16_t*)(ws + WS_BIG);
        bf16_t* oc = (bf16_t*)(ws + WS_AUX); float* lse = (float*)(ws + WS_AUX + AUX_LSE);
        bf16_t* qmla = (bf16_t*)(ws + WS_AUX); bf16_t* kvmla = (bf16_t*)(ws + WS_AUX + AUX_KV);
        const int li = ph / 12, st = ph % 12, jj = li >> 1; const bool even = (li & 1) == 0;
        if (ph < DEPTH * 12 && even && st == 5) continue;
        if (ph == DEPTH * 12) {
            final_norm_rows(hbf, hres, ap->in[I_FN], gw, NGW, lane);
        } else if (st == 0) {
            LAS float* scr = (LAS float*)(lds + wave * 8448);
            constexpr int I_UP = (DM / 64) * (2 * FF / 32), I_DN = (FF / 64) * (DM / 32), I_EIN = (DM / 64) * (EVEN_IN / 32), I_OIN = (DM / 64) * (ODD_IN / 32), I_OUT = (DM / 64) * (DM / 32),
                          I_QBI = (384 / 64) * (768 / 32), I_KVBI = (256 / 64) * (1024 / 32), I_PAD = ODD_INP - ODD_IN;
            const int n_in = even ? I_EIN : I_OIN;
            const int total = 2 * I_UP + 2 * I_DN + n_in + I_OUT + (even ? 0 : (I_QBI + I_KVBI + I_PAD));
            const size_t wff = (size_t)li * DM * FF;
            for (int it = gw; it < total; it += NGW) {
                int r = it;
                if (r < I_UP) { tr_up(ap->in[I_F1W1] + wff, ap->in[I_F1W3] + wff, (bf16_t*)(ws + W_UP1), r, scr, lane); continue; } r -= I_UP;
                if (r < I_UP) { tr_up(ap->in[I_F2W1] + wff, ap->in[I_F2W3] + wff, (bf16_t*)(ws + W_UP2), r, scr, lane); continue; } r -= I_UP;
                if (r < I_DN) { tr_plain(ap->in[I_F1W2] + wff, FF, DM, (bf16_t*)(ws + W_DN1), r, scr, lane); continue; } r -= I_DN;
                if (r < I_DN) { tr_plain(ap->in[I_F2W2] + wff, FF, DM, (bf16_t*)(ws + W_DN2), r, scr, lane); continue; } r -= I_DN;
                if (r < n_in) { if (even) tr_plain(ap->in[I_EWIN] + (size_t)jj * DM * EVEN_IN, DM, EVEN_IN, (bf16_t*)(ws + W_IN), r, scr, lane);
                                else tr_plain(ap->in[I_OWIN] + (size_t)jj * DM * ODD_IN, DM, ODD_IN, (bf16_t*)(ws + W_IN), r, scr, lane); continue; } r -= n_in;
                if (r < I_OUT) { tr_plain((even ? ap->in[I_EWOUT] : ap->in[I_OWOUT]) + (size_t)jj * DM * DM, DM, DM, (bf16_t*)(ws + W_OUT), r, scr, lane); continue; } r -= I_OUT;
                if (r < I_QBI) { tr_plain(ap->in[I_WQB] + (size_t)jj * 384 * 768, 384, 768, (bf16_t*)(ws + W_QB), r, scr, lane); continue; } r -= I_QBI;
                if (r < I_KVBI) { tr_plain(ap->in[I_WKVB] + (size_t)jj * 256 * 1024, 256, 1024, (bf16_t*)(ws + W_KVB), r, scr, lane); continue; } r -= I_KVBI;
                { u32x4* z = (u32x4*)((bf16_t*)(ws + W_IN) + (size_t)(ODD_IN + r) * DM); z[lane] = (u32x4){0u, 0u, 0u, 0u}; z[64 + lane] = (u32x4){0u, 0u, 0u, 0u}; }
            }
            if (li == 0) rmsnorm_rows(ap->in[I_X], ap->in[I_F1N], hn, gw, NGW, lane); else rmsnorm_rows_bf16(hbf, ap->in[I_F1N] + li * DM, hn, gw, NGW, lane);
        } else if (st == 1 || st == 10) {
            pg8::Gemm g{hn, (const bf16_t*)(ws + (st == 1 ? W_UP1 : W_UP2)), T, 2 * FF, DM, DM}; pg8::StaticOrder S; S.init(T, 2 * FF, G, bid);
            pg8::EpiSwiglu E{big, FF};
            pg8::gemm_phase<pg8::EpiSwiglu, pg8::StaticOrder>(lds, g, S, E, tid);
        } else if (st == 2 || st == 11) {
            pg8::Gemm g{big, (const bf16_t*)(ws + (st == 2 ? W_DN1 : W_DN2)), T, DM, FF, FF}; pg8::StaticOrder S; S.init(T, DM, G, bid);
            pg8::EpiResid E{(li == 0 && st == 2) ? ap->in[I_X] : (const float*)nullptr, hbf, DM, 0.5f};
            pg8::gemm_phase<pg8::EpiResid, pg8::StaticOrder>(lds, g, S, E, tid);
        } else if (st == 3 || st == 9) {
            rmsnorm_rows_bf16(hbf, (st == 3 ? ap->in[I_MIXN] : ap->in[I_F2N]) + li * DM, hn, gw, NGW, lane);
        } else if (st == 4) {
            const int N = even ? EVEN_IN : ODD_INP;
            pg8::Gemm g{hn, (const bf16_t*)(ws + W_IN), T, N, DM, DM}; pg8::StaticOrder S; S.init(T, N, G, bid);
            pg8::EpiBf16 E{big, N};
            pg8::gemm_phase<pg8::EpiBf16, pg8::StaticOrder>(lds, g, S, E, tid);
        } else if (st == 5) {
            if (even) {
                for (int row = gw; row < T; row += NGW) {
                    const int pos = row & (SEQ - 1); bf16_t* p = big + (size_t)row * EVEN_IN + (lane >> 2) * 64 + (lane & 3) * 8;
                    const u32x4 va = *(const u32x4*)(big + (size_t)row * EVEN_IN + 1024 + lane * 8);
                    u32x4 a = *(const u32x4*)p, b = *(const u32x4*)(p + 32);
                    rope8(a, b, cosT + pos * 32 + (lane & 3) * 8, sinT + pos * 32 + (lane & 3) * 8, 1);
                    bf16_t* kcr = hn + ((size_t)(row - pos) + ((pos & 15) << 8) + (pos >> 4)) * 1024;
                    if (lane < 32) { *(u32x4*)p = a; *(u32x4*)(p + 32) = b; }
                    else { bf16_t* kq = kcr + ((lane >> 2) - 8) * 64 + (lane & 3) * 8; *(u32x4*)kq = a; *(u32x4*)(kq + 32) = b; }
                    *(u32x4*)(kcr + 512 + lane * 8) = va;
                }
            } else {
                const float* qn = ap->in[I_QN] + jj * 384; const float* kvn = ap->in[I_KVN] + jj * 256;
                for (int row = gw; row < T; row += NGW) {
                    const int pos = row & (SEQ - 1); bf16_t* pr = big + (size_t)row * ODD_INP;
                    if (lane < 40) {
                        bf16_t* p = pr + (lane >> 2) * 64 + (lane & 3) * 8;
                        u32x4 a = *(const u32x4*)p, b = *(const u32x4*)(p + 32);
                        rope8(a, b, cosT + pos * 32 + (lane & 3) * 8, sinT + pos * 32 + (lane & 3) * 8, 1);
                        *(u32x4*)p = a; *(u32x4*)(p + 32) = b;
                    } else if (lane < 42) {
                        bf16_t* p = pr + 1408 + (lane - 40) * 8;
                        u32x4 a = *(const u32x4*)p, b = *(const u32x4*)(p + 16);
                        rope8(a, b, cosT + pos * 32 + (lane - 40) * 16, sinT + pos * 32 + (lane - 40) * 16, 2);
                        *(u32x4*)p = a; *(u32x4*)(p + 16) = b;
                    }
                    u32x4 qa = (u32x4){0u, 0u, 0u, 0u}, ka = (u32x4){0u, 0u, 0u, 0u};
                    if (lane < 48) qa = *(const u32x4*)(pr + 768 + lane * 8);
                    if (lane < 32) ka = *(const u32x4*)(pr + 1152 + lane * 8);
                    float sq = 0.f, sk = 0.f;
#pragma unroll
                    for (int j = 0; j < 4; ++j) { const float a0 = bf_lo(qa[j]), a1 = bf_hi(qa[j]), b0 = bf_lo(ka[j]), b1 = bf_hi(ka[j]); sq += a0 * a0 + a1 * a1; sk += b0 * b0 + b1 * b1; }
                    const float rq = 1.0f / sqrtf(wave_sum(sq) * (1.0f / 384.0f) + NORM_EPS), rk = 1.0f / sqrtf(wave_sum(sk) * (1.0f / 256.0f) + NORM_EPS);
                    if (lane < 48) { u32x4 w;
#pragma unroll
                        for (int j = 0; j < 4; ++j) w[j] = cvt_pk_bf16(bf_lo(qa[j]) * rq * qn[lane * 8 + 2 * j], bf_hi(qa[j]) * rq * qn[lane * 8 + 2 * j + 1]);
                        *(u32x4*)(pr + 768 + lane * 8) = w; }
                    if (lane < 32) { u32x4 w;
#pragma unroll
                        for (int j = 0; j < 4; ++j) w[j] = cvt_pk_bf16(bf_lo(ka[j]) * rk * kvn[lane * 8 + 2 * j], bf_hi(ka[j]) * rk * kvn[lane * 8 + 2 * j + 1]);
                        *(u32x4*)(pr + 1152 + lane * 8) = w; }
                }
            }
        } else if (st == 6) {
            if (even) {
                LAS unsigned char* wl = lds + wave * AW_BYTES;
                constexpr int NDIL = 3 * 8192, NNA = 8192;
                const float* rpb = ap->in[I_RPB] + (size_t)jj * 8 * 465;
                const int vcu = (G % 8 == 0) ? (bid % 8) * (G / 8) + bid / 8 : bid;
                const int h = wave;
                { constexpr int DK_KSTR = 144, DK_VHS = 416 * 64, DK_V = 416 * DK_KSTR, DK_WSF = DK_V + 2 * DK_VHS, DK_STG = DK_WSF + NWAVES * 256;
                  static_assert(DK_STG + NWAVES * 4096 <= LDS_BYTES - 64, "dilated LDS");
                  const int WPW = (3072 + G - 1) / G, w1 = (vcu + 1) * WPW < 3072 ? (vcu + 1) * WPW : 3072;
                  const int r32 = lane & 31, hi = lane >> 5;
                  { unsigned zz = 0u; asm volatile("" : "+v"(zz)); const u32x4 z4 = (u32x4){zz, zz, zz, zz};
                    if (tid < 288) *(LAS u32x4*)(lds + 384 * DK_KSTR + tid * 16) = z4;
                    if (tid < 256) *(LAS u32x4*)(lds + DK_V + (tid >> 7) * DK_VHS + 384 * 64 + (tid & 127) * 16) = z4; }
                  for (int wi = vcu * WPW; wi < w1; ++wi) {
                    const int hh_ = wi & 7, x16 = (wi >> 3) & 15, b = (wi >> 7) & 7, c = wi >> 10;
                    const int d = (c == 0) ? 1 : (c == 1) ? 4 : 16, nb = 16 / d, r = x16 / nb, ib = x16 % nb, sd = SEQ / d;
                    const int kb0 = 256 * ib - 64;
                    u32x4 ka[3], kb_[3], vreg[6];
                    const bf16_t* pb = big + (size_t)(b * SEQ) * EVEN_IN + hh_ * 64;
#pragma unroll
                    for (int j = 0; j < 3; ++j) { const int idx = tid + 512 * j, row = idx >> 2, c4 = idx & 3; const int tk = clampi(kb0 + row, 0, sd - 1) * d + r;
                        const bf16_t* gp = pb + (size_t)tk * EVEN_IN + 512 + c4 * 8; ka[j] = *(const u32x4*)gp; kb_[j] = *(const u32x4*)(gp + 32); }
#pragma unroll
                    for (int j = 0; j < 6; ++j) { const int idx = tid + 512 * j, row = idx >> 3, cc = idx & 7; const int tk = clampi(kb0 + row, 0, sd - 1) * d + r;
                        vreg[j] = *(const u32x4*)(pb + (size_t)tk * EVEN_IN + 1024 + cc * 8); }
                    const int ci0 = 256 * ib + 32 * wave;
                    DilSpec sp{big, hn, oc + (size_t)c * T * 512, lse + (size_t)c * T * 8, b, r, d, sd, ci0, hh_, ci0 - 64};
                    bf16x8 q[4];
                    { const bf16_t* qp = sp.qrow(r32);
#pragma unroll
                      for (int d0 = 0; d0 < 4; ++d0) q[d0] = *(const bf16x8*)(qp + d0 * 16 + hi * 8); }
                    __syncthreads();
#pragma unroll
                    for (int j = 0; j < 3; ++j) { const int idx = tid + 512 * j, row = idx >> 2, c4 = idx & 3; const int tk = clampi(kb0 + row, 0, sd - 1) * d + r;
                        rope8_fly(ka[j], kb_[j], (float)tk, c4 * 8);
                        *(LAS u32x4*)(lds + row * DK_KSTR + c4 * 16) = ka[j]; *(LAS u32x4*)(lds + row * DK_KSTR + (c4 + 4) * 16) = kb_[j]; }
#pragma unroll
                    for (int j = 0; j < 6; ++j) { const int idx = tid + 512 * j, row = idx >> 3, cc = idx & 7;
                        *(LAS u32x4*)(lds + DK_V + (cc >> 2) * DK_VHS + row * 64 + (cc & 3) * 16) = vreg[j]; }
                    { const float qpos = (float)((ci0 + r32) * d + r);
                      u32x4 a0 = __builtin_bit_cast(u32x4, q[0]), b0 = __builtin_bit_cast(u32x4, q[2]), a1 = __builtin_bit_cast(u32x4, q[1]), b1 = __builtin_bit_cast(u32x4, q[3]);
                      rope8_fly(a0, b0, qpos, 8 * hi); rope8_fly(a1, b1, qpos, 16 + 8 * hi);
                      q[0] = __builtin_bit_cast(bf16x8, a0); q[2] = __builtin_bit_cast(bf16x8, b0); q[1] = __builtin_bit_cast(bf16x8, a1); q[3] = __builtin_bit_cast(bf16x8, b1); }
                    f32x16 o[2];
#pragma unroll
                    for (int rr = 0; rr < 16; ++rr) { o[0][rr] = 0.f; o[1][rr] = 0.f; }
                    float m = -INFINITY, l = 0.f;
                    LAS float* wsf = (LAS float*)(lds + DK_WSF + wave * 256);
                    __syncthreads();
                    for (int t = 0; t < 3; ++t) {
                        if (sp.skip(t)) continue;
                        const int ro = 32 * wave + 64 * t;
                        u32x4 pw[4];
                        attn_scores<4, DilSpec>(q, lds + ro * DK_KSTR, DK_KSTR, o, m, l, sp, t, wsf, lane, pw);
                        attn_pv(pw, lds + DK_V + ro * 64, o, lane, DK_VHS);
                    }
                    const float lt = attn_finish(o, l, sp, wsf, (LAS bf16_t*)(lds + DK_STG + wave * 4096), lane);
                    sp.finish(m, lt, r32, hi);
                  }
                  __syncthreads(); }
                { constexpr int NK_ROWS = 120, NK_KSTR = 144, NK_VHS = NK_ROWS * 64, NK_KB = NK_ROWS * NK_KSTR, NK_BUF = NK_KB + 2 * NK_VHS, NK_WSF = 2 * NK_BUF, NK_BIAS = NK_WSF + NWAVES * 256, NK_STG = NK_BIAS + 2048;
                  static_assert(NK_STG + NWAVES * 4096 <= LDS_BYTES - 64, "neighbourhood LDS");
                  const int WPW = (1024 + G - 1) / G, w1 = (vcu + 1) * WPW < 1024 ? (vcu + 1) * WPW : 1024;
                  const int r32 = lane & 31, hi = lane >> 5;
                  for (int wi = vcu * WPW; wi < w1; ++wi) {
                    const int hh_ = wi & 7, g8 = (wi >> 3) & 7, hf = (wi >> 6) & 1, b = wi >> 7;
                    const int gr = 8 * g8 + wave, rsw = clampi(gr - 4, 0, 56), rmin = clampi(8 * g8 - 4, 0, 56), rmax = clampi(8 * g8 + 3, 0, 56) + 7, nch = (rmax - rmin + 1) * 64;
                    const int cb = hf ? 24 : 0;
                    const bf16_t* kvb = big + (size_t)(b * SEQ) * EVEN_IN + hh_ * 64;
                    u32x4 kreg[2], vreg[2];
#define NK_LOAD(tt) do { _Pragma("unroll") for (int j = 0; j < 2; ++j) { const int idx = tid + 512 * j; if (idx < nch) { const int row = idx >> 3, cc = idx & 7; \
                        const bf16_t* gp = kvb + (size_t)((rmin + (row >> 3)) * 64 + cb + 8 * (tt) + (row & 7)) * EVEN_IN + cc * 8; kreg[j] = *(const u32x4*)(gp + 2048); vreg[j] = *(const u32x4*)(gp + 2560); } } } while (0)
#define NK_STORE(bf) do { _Pragma("unroll") for (int j = 0; j < 2; ++j) { const int idx = tid + 512 * j; if (idx < nch) { const int row = idx >> 3, cc = idx & 7; \
                        *(LAS u32x4*)(lds + (bf) * NK_BUF + row * NK_KSTR + cc * 16) = kreg[j]; *(LAS u32x4*)(lds + (bf) * NK_BUF + NK_KB + (cc >> 2) * NK_VHS + row * 64 + (cc & 3) * 16) = vreg[j]; } } } while (0)
                    NK_LOAD(0);
                    LAS float* bt = (LAS float*)(lds + NK_BIAS);
                    NaSpec sp{big, mixed, bt, b, gr, hf, hh_, rsw, cb};
                    bf16x8 q[4];
                    { const bf16_t* qp = sp.qrow(r32);
#pragma unroll
                      for (int d0 = 0; d0 < 4; ++d0) q[d0] = *(const bf16x8*)(qp + d0 * 16 + hi * 8); }
                    const float bv = (tid < 465) ? 8.0f * rpb[hh_ * 465 + tid] : 0.f;
                    __syncthreads();
                    NK_STORE(0); if (tid < 465) bt[tid] = bv;
                    NK_LOAD(1);
                    f32x16 o[2];
#pragma unroll
                    for (int rr = 0; rr < 16; ++rr) { o[0][rr] = 0.f; o[1][rr] = 0.f; }
                    float m = -INFINITY, l = 0.f;
                    LAS float* wsf = (LAS float*)(lds + NK_WSF + wave * 256);
                    const int ro = (rsw - rmin) * 8;
                    __syncthreads();
                    for (int t = 0; t < 5; ++t) {
                        const int cur = t & 1;
                        if (t + 1 < 5) NK_STORE(cur ^ 1);
                        if (t + 2 < 5) NK_LOAD(t + 2);
                        u32x4 pw[4];
                        attn_scores<4, NaSpec>(q, lds + cur * NK_BUF + ro * NK_KSTR, NK_KSTR, o, m, l, sp, t, wsf, lane, pw);
                        attn_pv(pw, lds + cur * NK_BUF + NK_KB + ro * 64, o, lane, NK_VHS);
                        __syncthreads();
                    }
                    attn_finish(o, l, sp, wsf, (LAS bf16_t*)(lds + NK_STG + wave * 4096), lane);
#undef NK_LOAD
#undef NK_STORE
                  }
                  __syncthreads(); }
            } else {
                { pg8::Gemm g{big + 768, (const bf16_t*)(ws + W_QB), T, 768, 384, ODD_INP}; pg8::StaticOrder S; S.init(T, 768, G, bid);
                  pg8::EpiBf16 E{qmla, 768}; pg8::gemm_phase<pg8::EpiBf16, pg8::StaticOrder>(lds, g, S, E, tid); }
                { pg8::Gemm g{big + 1152, (const bf16_t*)(ws + W_KVB), T, 1024, 256, ODD_INP}; pg8::StaticOrder S; S.init(T, 1024, G, bid);
                  pg8::EpiBf16 E{kvmla, 1024}; pg8::gemm_phase<pg8::EpiBf16, pg8::StaticOrder>(lds, g, S, E, tid); }
            }
        } else if (st == 7) {
            if (even) {
                for (int row = gw; row < T; row += NGW) {
                    const int h = lane >> 3;
                    const float l0 = lse[(size_t)row * 8 + h], l1 = lse[(size_t)T * 8 + (size_t)row * 8 + h], l2 = lse[(size_t)2 * T * 8 + (size_t)row * 8 + h];
                    const float mx = fmaxf(l0, fmaxf(l1, l2)); float w0 = __expf(l0 - mx), w1 = __expf(l1 - mx), w2 = __expf(l2 - mx); const float inv = 1.0f / (w0 + w1 + w2); w0 *= inv; w1 *= inv; w2 *= inv;
                    const u32x4 a = *(const u32x4*)(oc + (size_t)row * 512 + lane * 8), b = *(const u32x4*)(oc + (size_t)T * 512 + (size_t)row * 512 + lane * 8), c = *(const u32x4*)(oc + (size_t)2 * T * 512 + (size_t)row * 512 + lane * 8);
                    u32x4 w;
#pragma unroll
                    for (int j = 0; j < 4; ++j) w[j] = cvt_pk_bf16(w0 * bf_lo(a[j]) + w1 * bf_lo(b[j]) + w2 * bf_lo(c[j]), w0 * bf_hi(a[j]) + w1 * bf_hi(b[j]) + w2 * bf_hi(c[j]));
                    *(u32x4*)(mixed + (size_t)row * DM + lane * 8) = w;
                }
            } else {

#if EN_MLA
                for (int u = bid; u < 1024; u += G) {
                    const int h = u & 7, qb = (u >> 3) & 15, b = u >> 7;
                    const int r32 = lane & 31, hi = lane >> 5;
                    const int tok0 = b * SEQ + 256 * qb + 32 * wave;
                    bf16x8 q[6];
                    { const bf16_t* qp = qmla + (size_t)(tok0 + r32) * 768 + h * 96;
#pragma unroll
                      for (int d0 = 0; d0 < 6; ++d0) q[d0] = *(const bf16x8*)(qp + d0 * 16 + hi * 8);
                      const int pos = (tok0 + r32) & (SEQ - 1);
                      u32x4 a = __builtin_bit_cast(u32x4, q[4]), bb = __builtin_bit_cast(u32x4, q[5]);
                      rope8(a, bb, cosT + pos * 32 + hi * 16, sinT + pos * 32 + hi * 16, 2);
                      q[4] = __builtin_bit_cast(bf16x8, a); q[5] = __builtin_bit_cast(bf16x8, bb); }
                    f32x16 o[2];
#pragma unroll
                    for (int r = 0; r < 16; ++r) { o[0][r] = 0.f; o[1][r] = 0.f; }
                    float m = -INFINITY, l = 0.f;
                    MlaSpec sp{mixed, tok0, h};
                    LAS float* wsf = (LAS float*)(lds + ML_WSF + wave * 256);
                    const int krow = tid >> 3, kc = tid & 7, prow = (tid & 255) >> 2, pc = tid & 3;
                    const bf16_t* kvp = kvmla + (size_t)(b * SEQ + krow) * 1024 + h * 128 + kc * 8;
                    const bf16_t* pep = big + (size_t)(b * SEQ + prow) * ODD_INP + 1408 + pc * 8;
                    u32x4 kn, vv, pe = (u32x4){0u, 0u, 0u, 0u};
#define MLA_LOAD(tt) do { kn = *(const u32x4*)(kvp + (size_t)(tt) * 64 * 1024); vv = *(const u32x4*)(kvp + (size_t)(tt) * 64 * 1024 + 64); if (tid < 256) pe = *(const u32x4*)(pep + (size_t)(tt) * 64 * ODD_INP); } while (0)
#define MLA_STORE(slot) do { *(LAS u32x4*)(lds + ML_K0 + (slot) * ML_KB + krow * ML_KSTRIDE + kc * 16) = kn; *(LAS u32x4*)(lds + ML_V0 + (slot) * ML_VB + (kc >> 2) * 4096 + krow * 64 + (kc & 3) * 16) = vv; \
                        if (tid < 256) *(LAS u32x4*)(lds + ML_K0 + (slot) * ML_KB + prow * ML_KSTRIDE + 128 + pc * 16) = pe; } while (0)
                    MLA_LOAD(0);
                    __syncthreads();
                    MLA_STORE(0); MLA_LOAD(1); MLA_STORE(1); MLA_LOAD(2);
                    __syncthreads();
                    f32x16 pA0, pA1, pB0, pB1;
                    { const LAS unsigned char* kp = lds + ML_K0 + r32 * ML_KSTRIDE + hi * 16;
#pragma unroll
                      for (int r = 0; r < 16; ++r) { pA0[r] = 0.f; pA1[r] = 0.f; pB0[r] = 0.f; pB1[r] = 0.f; }
#pragma unroll
                      for (int d0 = 0; d0 < 6; ++d0) { pA0 = MFMA32(*(const LAS bf16x8*)(kp + d0 * 32), q[d0], pA0); pA1 = MFMA32(*(const LAS bf16x8*)(kp + 32 * ML_KSTRIDE + d0 * 32), q[d0], pA1); } }
                    int s0 = 0, s1 = 1, s2 = 2;
#define MLA_ROT() do { const int s_ = s0; s0 = s1; s1 = s2; s2 = s_; } while (0)
                    for (int t = 0; t < 62; t += 2) {
                        MLA_STORE(s2); if (t + 3 < 64) MLA_LOAD(t + 3);
                        dense_step<6, true>(q, lds + ML_K0 + s1 * ML_KB, ML_KSTRIDE, lds + ML_V0 + s0 * ML_VB, pA0, pA1, pB0, pB1, o, m, l, MlaSpec::SC, wsf, lane);
                        __syncthreads(); MLA_ROT();
                        if (t + 3 < 64) { MLA_STORE(s2); } if (t + 4 < 64) MLA_LOAD(t + 4);
                        dense_step<6, true>(q, lds + ML_K0 + s1 * ML_KB, ML_KSTRIDE, lds + ML_V0 + s0 * ML_VB, pB0, pB1, pA0, pA1, o, m, l, MlaSpec::SC, wsf, lane);
                        __syncthreads(); MLA_ROT();
                    }
                    dense_step<6, true>(q, lds + ML_K0 + s1 * ML_KB, ML_KSTRIDE, lds + ML_V0 + s0 * ML_VB, pA0, pA1, pB0, pB1, o, m, l, MlaSpec::SC, wsf, lane);
                    __syncthreads(); MLA_ROT();
                    dense_step<6, false>(q, lds + ML_K0 + s1 * ML_KB, ML_KSTRIDE, lds + ML_V0 + s0 * ML_VB, pB0, pB1, pA0, pA1, o, m, l, MlaSpec::SC, wsf, lane);
#undef MLA_LOAD
#undef MLA_STORE
#undef MLA_ROT
                    attn_finish(o, l, sp, wsf, (LAS bf16_t*)(lds + ML_STG + wave * 4096), lane);
                }

#endif
                __syncthreads();
                LAS unsigned char* wl = lds + wave * AW_BYTES;
                const float* sink = ap->in[I_SINK] + jj * 8;

#if EN_SWA
                { const int vcu = (G % 8 == 0) ? (bid % 8) * (G / 8) + bid / 8 : bid, hq = wave;
                  const int PPW = (1024 + G - 1) / G, p1 = (vcu + 1) * PPW < 1024 ? (vcu + 1) * PPW : 1024;
                  for (int p = vcu * PPW; p < p1; ++p) {
                    const int qc = p & 127, b = p >> 7;
                    SwaSpec sp{big, mixed, b, hq, hq >> 2, 32 * qc, 32 * qc - 128};
                    attn_wave_item(sp, wl, lane, sink[hq] * LOG2E, 1.0f);
                  } }

#endif
            }
        } else if (st == 8) {
            pg8::Gemm g{mixed, (const bf16_t*)(ws + W_OUT), T, DM, DM, DM}; pg8::StaticOrder S; S.init(T, DM, G, bid);
            pg8::EpiResid E{(const float*)nullptr, hbf, DM, 1.0f};
            pg8::gemm_phase<pg8::EpiResid, pg8::StaticOrder>(lds, g, S, E, tid);
        }
#if PROBE_DUP
        { const bool isatt = (ph < DEPTH * 12) && ((even && st == 6) || (!even && st == 7));
          const bool ismisc = (ph < DEPTH * 12) && (st == 0 || st == 3 || st == 9 || (even && st == 7));
          const bool isup = (ph < DEPTH * 12) && (st == 1 || st == 10);
          if (!dup_done && ((PROBE_DUP == 1 && isatt) || (PROBE_DUP == 2 && ismisc) || (PROBE_DUP == 3 && isup))) { dup_done = true; --ph; } else dup_done = false; }
#endif
        if (ph + 1 < args.ph_hi) {
            if (ph == args.ph_lo) { __syncthreads(); grid.sync(); }
            else xcd_barrier(xbar);
            if (PROBE_DUP == 4) xcd_barrier(xbar);
        }
    }
}

extern "C" void kernel_launch(void* const* d_in, const int* in_sizes, int n_in, void* d_out, int out_size, void* d_ws, size_t ws_size, hipStream_t stream) {
    static int grid = 0;
    if (grid == 0) {
        if (n_in != 21 || ws_size < WS_END) { fprintf(stderr, "kernel_launch: unexpected inputs (n_in %d, ws %zu < %zu)\n", n_in, ws_size, (size_t)WS_END); grid = -1; return; }
        int dev = 0, cus = 0, per_cu = 0;
        hipGetDevice(&dev); hipDeviceGetAttribute(&cus, hipDeviceAttributeMultiprocessorCount, dev);
        if (hipFuncSetAttribute((const void*)fwd_megakernel, hipFuncAttributeMaxDynamicSharedMemorySize, LDS_BYTES) != hipSuccess) { fprintf(stderr, "kernel_launch: hipFuncSetAttribute failed\n"); grid = -1; return; }
        if (hipOccupancyMaxActiveBlocksPerMultiprocessor(&per_cu, (const void*)fwd_megakernel, NTHREADS, LDS_BYTES) != hipSuccess || per_cu < 1) { fprintf(stderr, "kernel_launch: occupancy query gave %d\n", per_cu); per_cu = 1; }
        (void)hipGetLastError();
        grid = cus * per_cu;
    }
    if (grid < 0) return;
    Args a{};
    for (int i = 0; i < 21; ++i) a.in[i] = (const float*)d_in[i];
    a.out = (float*)d_out; a.ws = (unsigned char*)d_ws;
    a.ph_lo = 0; a.ph_hi = DEPTH * 12 + 1;
    if (hipMemsetAsync((char*)d_ws + WS_BAR, 0, 16384, stream) != hipSuccess) { fprintf(stderr, "kernel_launch: memset failed\n"); return; }
    void* kargs[] = {&a};
    hipError_t e = hipLaunchCooperativeKernel((const void*)fwd_megakernel, dim3(grid), dim3(NTHREADS), kargs, LDS_BYTES, stream);
    if (e != hipSuccess) fprintf(stderr, "cooperative launch failed: %s (grid %d)\n", hipGetErrorString(e), grid);
}
```

```cpp
#include <hip/hip_runtime.h>
#include <hip/hip_cooperative_groups.h>
#include <cstdio>
#include <cstdint>
#include <cmath>
namespace cg = cooperative_groups;
#ifndef EN_DIL
#define EN_DIL 1
#endif
#ifndef EN_NA
#define EN_NA 1
#endif
#ifndef EN_MLA
#define EN_MLA 1
#endif
#ifndef EN_SWA
#define EN_SWA 1
#endif
#ifndef EN_GEMM
#define EN_GEMM 1
#endif
#ifndef EN_MISC
#define EN_MISC 1
#endif

#define LAS __attribute__((address_space(3)))
typedef unsigned short bf16_t;
typedef short bf16x8 __attribute__((ext_vector_type(8)));
typedef short s16x4 __attribute__((ext_vector_type(4)));
typedef float f32x4 __attribute__((ext_vector_type(4)));
typedef float f32x16 __attribute__((ext_vector_type(16)));
typedef unsigned u32x4 __attribute__((ext_vector_type(4)));
typedef unsigned u32x2 __attribute__((ext_vector_type(2)));

constexpr int T = 32768, DM = 1024, FF = 2816, SEQ = 4096, DEPTH = 4;
constexpr int EVEN_IN = 3072, ODD_IN = 1440, ODD_INP = 1536;
constexpr float NORM_EPS = 1e-6f;
constexpr float LOG2E = 1.4426950408889634f, LN2 = 0.6931471805599453f;
constexpr int NTHREADS = 512, NWAVES = 8;
constexpr int LDS_BYTES = 163840;

constexpr size_t MiB = 1u << 20;
constexpr size_t WS_COS = 0, WS_SIN = 512 * 1024;
constexpr size_t WS_W = 1 * MiB;
constexpr size_t W_UP1 = WS_W, W_DN1 = W_UP1 + (size_t)2 * FF * DM * 2, W_UP2 = W_DN1 + (size_t)DM * FF * 2, W_DN2 = W_UP2 + (size_t)2 * FF * DM * 2,
                 W_IN = W_DN2 + (size_t)DM * FF * 2, W_OUT = W_IN + (size_t)EVEN_IN * DM * 2, W_QB = W_OUT + (size_t)DM * DM * 2, W_KVB = W_QB + (size_t)768 * 384 * 2,
                 W_END = W_KVB + (size_t)1024 * 256 * 2;
static_assert(W_END <= 49 * MiB, "weights region");
constexpr size_t WS_HN = 49 * MiB;
constexpr size_t WS_BIG = WS_HN + 64 * MiB;
constexpr size_t WS_AUX = WS_BIG + 192 * MiB;
constexpr size_t AUX_LSE = 96 * MiB, AUX_KV = 48 * MiB;
constexpr size_t WS_NAO = WS_AUX + 116 * MiB;
constexpr size_t WS_BAR = WS_NAO + 64 * MiB;
constexpr size_t WS_END = WS_BAR + 16384;

__device__ __forceinline__ unsigned cvt_pk_bf16(float lo, float hi) { unsigned r; asm volatile("v_cvt_pk_bf16_f32 %0, %1, %2" : "=v"(r) : "v"(lo), "v"(hi)); return r; }
__device__ __forceinline__ float bf_lo(unsigned w) { return __uint_as_float(w << 16); }
__device__ __forceinline__ float bf_hi(unsigned w) { return __uint_as_float(w & 0xffff0000u); }
typedef _Float16 h16x2 __attribute__((ext_vector_type(2)));
__device__ __forceinline__ unsigned pk_f16(float lo, float hi) { const h16x2 v = (h16x2){(_Float16)lo, (_Float16)hi}; return __builtin_bit_cast(unsigned, v); }
__device__ __forceinline__ float f16_lo(unsigned w) { return (float)__builtin_bit_cast(h16x2, w)[0]; }
__device__ __forceinline__ float f16_hi(unsigned w) { return (float)__builtin_bit_cast(h16x2, w)[1]; }
template <int MASK> __device__ __forceinline__ float swz_xor(float v) { return __int_as_float(__builtin_amdgcn_ds_swizzle(__float_as_int(v), (MASK << 10) | 0x1f)); }
__device__ __forceinline__ float half_sum(float v) { auto rr = __builtin_amdgcn_permlane32_swap(__float_as_uint(v), __float_as_uint(v), false, false); return __uint_as_float(rr[0]) + __uint_as_float(rr[1]); }
__device__ __forceinline__ float half_max(float v) { auto rr = __builtin_amdgcn_permlane32_swap(__float_as_uint(v), __float_as_uint(v), false, false); return fmaxf(__uint_as_float(rr[0]), __uint_as_float(rr[1])); }
__device__ __forceinline__ float wave_sum(float v) {
    v += swz_xor<1>(v); v += swz_xor<2>(v); v += swz_xor<4>(v); v += swz_xor<8>(v); v += swz_xor<16>(v);
    return half_sum(v);
}
__device__ __forceinline__ float max3f(float a, float b, float c) { float r; asm("v_max3_f32 %0, %1, %2, %3" : "=v"(r) : "v"(a), "v"(b), "v"(c)); return r; }
__device__ __forceinline__ int crow(int r, int hi) { return (r & 3) + 8 * (r >> 2) + 4 * hi; }
__device__ __forceinline__ int clampi(int v, int lo, int hi) { return v < lo ? lo : (v > hi ? hi : v); }

namespace pg8 {
constexpr int BM = 256, BK = 64, HALF = 128, HTB = HALF * BK * 2  , STAGE_BYTES = 8 * HTB, NXCD = 8, WGM = 8;

__host__ __device__ __forceinline__ int lds_byte(int r, int c) { const int st = (r >> 4) * 2 + (c >> 5), rr = r & 15, cc = c & 31, ob = rr * 64 + cc * 2; return st * 1024 + (ob ^ (((ob >> 9) & 1) << 5)); }
__host__ __device__ __forceinline__ void stage_rc(int b, int& R, int& C) { const int st = b / 1024, sb = b % 1024, swz = sb ^ (((sb >> 9) & 1) << 5); R = (st >> 1) * 16 + swz / 64; C = (st & 1) * 32 + (swz % 64) / 2; }
__host__ __device__ __forceinline__ int perm32(int rho) { const int n = rho >> 4, i = rho & 15; return 8 * (i >> 2) + 4 * n + (i & 3); }

struct Unit { int pm, pn; };
struct Gemm { const bf16_t* A; const bf16_t* Bt; int M, N, K, lda; };

struct StaticOrder {
    int nM, nN, nwg, G, c;
    __host__ __device__ void init(int M, int N, int G_, int c_) { nM = M / BM; nN = N / BM; nwg = nM * nN; G = G_; c = c_; }
    __host__ __device__ bool next(int i, Unit& u) const {
        const long L = (long)i * G + c; if (L >= nwg) return false;
        int wgid = (int)L; { const int q = nwg / NXCD, r = nwg % NXCD, xcd = wgid % NXCD, off = wgid / NXCD; wgid = (xcd < r ? xcd * (q + 1) : r * (q + 1) + (xcd - r) * q) + off; }
        const int nig = WGM * nN, gid = wgid / nig, fm = gid * WGM, gsz = (nM - fm) < WGM ? (nM - fm) : WGM;
        u.pm = fm + ((wgid % nig) % gsz); u.pn = (wgid % nig) / gsz; return true;
    }
};


struct EpiBf16 {
    static constexpr bool PERM = true;
    bf16_t* O; int ldc;
    __device__ __forceinline__ void operator()(const f32x4 (&acc)[2][2][4][2], const Unit& u, int wr, int wc, int fr, int fq) const {
        const int row0 = u.pm * BM + wr * 64 + fr; const int col0 = u.pn * BM + wc * 32 + 8 * fq;
#pragma unroll
        for (int ai = 0; ai < 2; ++ai)
#pragma unroll
            for (int m = 0; m < 4; ++m) { bf16_t* rowp = O + (size_t)(row0 + ai * HALF + m * 16) * ldc + col0;
#pragma unroll
                for (int bj = 0; bj < 2; ++bj) { const f32x4 v0 = acc[ai][bj][m][0], v1 = acc[ai][bj][m][1];
                    u32x4 w; w.x = cvt_pk_bf16(v0[0], v0[1]); w.y = cvt_pk_bf16(v0[2], v0[3]); w.z = cvt_pk_bf16(v1[0], v1[1]); w.w = cvt_pk_bf16(v1[2], v1[3]);
                    *(u32x4*)(rowp + bj * HALF) = w; } }
    }
};
struct EpiSwiglu {
    static constexpr bool PERM = true;
    bf16_t* O; int ldc;
    __device__ __forceinline__ float sg(float a, float b) const { const float e = __builtin_amdgcn_exp2f(-a * LOG2E); return a * b * __builtin_amdgcn_rcpf(1.0f + e); }
    __device__ __forceinline__ void operator()(const f32x4 (&acc)[2][2][4][2], const Unit& u, int wr, int wc, int fr, int fq) const {
        const int row0 = u.pm * BM + wr * 64 + fr; const int col0 = u.pn * HALF + wc * 32 + 8 * fq;
#pragma unroll
        for (int ai = 0; ai < 2; ++ai)
#pragma unroll
            for (int m = 0; m < 4; ++m) { bf16_t* rowp = O + (size_t)(row0 + ai * HALF + m * 16) * ldc + col0;
                const f32x4 a0 = acc[ai][0][m][0], a1 = acc[ai][0][m][1], b0 = acc[ai][1][m][0], b1 = acc[ai][1][m][1];
                u32x4 w; w.x = cvt_pk_bf16(sg(a0[0], b0[0]), sg(a0[1], b0[1])); w.y = cvt_pk_bf16(sg(a0[2], b0[2]), sg(a0[3], b0[3]));
                w.z = cvt_pk_bf16(sg(a1[0], b1[0]), sg(a1[1], b1[1])); w.w = cvt_pk_bf16(sg(a1[2], b1[2]), sg(a1[3], b1[3]));
                *(u32x4*)rowp = w; }
    }
};
struct EpiResid {
    static constexpr bool PERM = false;
    const float* basef; bf16_t* h; int ldc; float scale;
    __device__ __forceinline__ void operator()(const f32x4 (&acc)[2][2][4][2], const Unit& u, int wr, int wc, int fr, int fq) const {
        const int col0 = u.pn * BM + wc * 32 + 4 * fq;
#pragma unroll
        for (int ai = 0; ai < 2; ++ai)
#pragma unroll
            for (int m = 0; m < 4; ++m) { const size_t off = (size_t)(u.pm * BM + ai * HALF + wr * 64 + m * 16 + fr) * ldc + col0;
#pragma unroll
                for (int bj = 0; bj < 2; ++bj)
#pragma unroll
                    for (int n = 0; n < 2; ++n) { f32x4 bs;
                        if (basef) bs = *(const f32x4*)(basef + off + bj * HALF + n * 16);
                        else { const u32x2 w = *(const u32x2*)(h + off + bj * HALF + n * 16); bs = (f32x4){f16_lo(w.x), f16_hi(w.x), f16_lo(w.y), f16_hi(w.y)}; }
                        const f32x4 o = bs + acc[ai][bj][m][n] * scale;
                        u32x2 wo; wo.x = pk_f16(o[0], o[1]); wo.y = pk_f16(o[2], o[3]); *(u32x2*)(h + off + bj * HALF + n * 16) = wo; }
                asm volatile("" ::: "memory"); }
    }
};

template <class Epi, class Sched>
__device__ __forceinline__ void gemm_phase(LAS unsigned char* lds, const Gemm g, const Sched& S, const Epi& E, const int tid) {
    const int wid = __builtin_amdgcn_readfirstlane(tid >> 6), lane = tid & 63, wr = wid >> 2, wc = wid & 3, fr = lane & 15, fq = lane >> 4;
    const int K = g.K, nt = K / BK, lda = g.lda;
    unsigned voffA[2], voffB[2];
#pragma unroll
    for (int i = 0; i < 2; ++i) { int R, C; stage_rc(tid * 16 + i * 8192, R, C); const int Rb = Epi::PERM ? ((R & ~31) + perm32(R & 31)) : R;
        voffA[i] = (unsigned)(R * lda + C) * 2u; voffB[i] = (unsigned)(Rb * K + C) * 2u; }
    const size_t kstep = (size_t)(BK * 2);
    const size_t hstepA = (size_t)HALF * lda * 2, hstepB = (size_t)HALF * K * 2;
    const size_t tstepA = 2 * hstepA, tstepB = 2 * hstepB;
    const unsigned ldsw = (unsigned)wid * 1024u;
    const int aoff = lds_byte(wr * 64 + fr, fq * 8), boff = lds_byte(wc * 32 + fr, fq * 8);
#define PG8_SA(b, h) (((b) * 2 + (h)) * HTB)
#define PG8_SB(b, h) ((4 + (b) * 2 + (h)) * HTB)
#define PG8_STAGE(bufoff, gbase, voff) do { _Pragma("unroll") for (int _i = 0; _i < 2; ++_i) \
        __builtin_amdgcn_global_load_lds((const unsigned*)((const char*)(gbase) + (voff)[_i]), (LAS unsigned*)(lds + (bufoff) + ldsw + _i * 8192), 16, 0, 0); } while (0)
#define PG8_LDA(dst, b, h) do { _Pragma("unroll") for (int m = 0; m < 4; ++m) _Pragma("unroll") for (int k = 0; k < 2; ++k) dst[m][k] = *(const LAS bf16x8*)(lds + PG8_SA(b, h) + aoff + m * 2048 + k * 1024); } while (0)
#define PG8_LDB(dst, b, h) do { _Pragma("unroll") for (int n = 0; n < 2; ++n) _Pragma("unroll") for (int k = 0; k < 2; ++k) dst[n][k] = *(const LAS bf16x8*)(lds + PG8_SB(b, h) + boff + n * 2048 + k * 1024); } while (0)
#define PG8_MMA(ai, bj, At, Bt) do { __builtin_amdgcn_s_setprio(1); _Pragma("unroll") for (int m = 0; m < 4; ++m) _Pragma("unroll") for (int n = 0; n < 2; ++n) _Pragma("unroll") for (int k = 0; k < 2; ++k) \
        acc[ai][bj][m][n] = __builtin_amdgcn_mfma_f32_16x16x32_bf16(Bt[n][k], At[m][k], acc[ai][bj][m][n], 0, 0, 0); __builtin_amdgcn_s_setprio(0); } while (0)
#define PG8_WAIT_V(n) asm volatile("s_waitcnt vmcnt(" #n ")" ::: "memory")
#define PG8_WAIT_L(n) asm volatile("s_waitcnt lgkmcnt(" #n ")" ::: "memory")
#define PG8_BAR __builtin_amdgcn_s_barrier()
#define PG8_SCHED __builtin_amdgcn_sched_barrier(0)
    Unit cur, nxt; int ui = 0;
    if (!S.next(0, cur)) return;
    f32x4 acc[2][2][4][2];
#pragma unroll
    for (int a = 0; a < 2; ++a)
#pragma unroll
        for (int b = 0; b < 2; ++b)
#pragma unroll
            for (int m = 0; m < 4; ++m)
#pragma unroll
                for (int n = 0; n < 2; ++n) acc[a][b][m][n] = (f32x4){0.f, 0.f, 0.f, 0.f};
    bf16x8 At[4][2], B0[2][2], B1[2][2];
    const char* cA = (const char*)g.A + (size_t)cur.pm * tstepA; const char* cB = (const char*)g.Bt + (size_t)cur.pn * tstepB;
    PG8_STAGE(PG8_SB(0, 0), cB, voffB); PG8_STAGE(PG8_SB(0, 1), cB + hstepB, voffB); PG8_STAGE(PG8_SA(0, 0), cA, voffA); PG8_STAGE(PG8_SA(0, 1), cA + hstepA, voffA);
    if (wr == 1) PG8_BAR;
    PG8_WAIT_V(2); PG8_BAR;
    PG8_STAGE(PG8_SB(1, 0), cB + kstep, voffB); PG8_STAGE(PG8_SA(1, 0), cA + kstep, voffA); PG8_STAGE(PG8_SB(1, 1), cB + hstepB + kstep, voffB);
    PG8_WAIT_V(6); PG8_BAR;
    for (;;) {
        const bool has_next = S.next(ui + 1, nxt);
        const char* nA = has_next ? (const char*)g.A + (size_t)nxt.pm * tstepA : cA; const char* nB = has_next ? (const char*)g.Bt + (size_t)nxt.pn * tstepB : cB;
        for (int t = 0; t < nt; t += 2) {
            const bool last = (t == nt - 2);
            const char* a1 = cA + (size_t)(t + 1) * kstep;
            const char* a2 = last ? nA : cA + (size_t)(t + 2) * kstep; const char* b2 = last ? nB : cB + (size_t)(t + 2) * kstep;
            const char* a3 = a2 + kstep; const char* b3 = b2 + kstep;
            PG8_LDB(B0, 0, 0); PG8_LDB(B1, 0, 1); PG8_SCHED; PG8_LDA(At, 0, 0); PG8_STAGE(PG8_SA(1, 1), a1 + hstepA, voffA);
            PG8_WAIT_V(8); PG8_WAIT_L(0); PG8_BAR; PG8_MMA(0, 0, At, B0); PG8_MMA(0, 1, At, B1); PG8_BAR; PG8_SCHED;
            PG8_LDA(At, 0, 1); PG8_STAGE(PG8_SB(0, 0), b2, voffB); PG8_STAGE(PG8_SB(0, 1), b2 + hstepB, voffB); PG8_STAGE(PG8_SA(0, 0), a2, voffA);
            PG8_WAIT_V(8); PG8_WAIT_L(0); PG8_BAR; PG8_MMA(1, 0, At, B0); PG8_MMA(1, 1, At, B1); PG8_BAR; PG8_SCHED;
            PG8_LDB(B0, 1, 0); PG8_LDB(B1, 1, 1); PG8_SCHED; PG8_LDA(At, 1, 0); PG8_STAGE(PG8_SA(0, 1), a2 + hstepA, voffA);
            PG8_WAIT_V(8); PG8_WAIT_L(0); PG8_BAR; PG8_MMA(0, 0, At, B0); PG8_MMA(0, 1, At, B1); PG8_BAR; PG8_SCHED;
            PG8_LDA(At, 1, 1); PG8_STAGE(PG8_SB(1, 0), b3, voffB); PG8_STAGE(PG8_SB(1, 1), b3 + hstepB, voffB); PG8_STAGE(PG8_SA(1, 0), a3, voffA);
            PG8_WAIT_V(8); PG8_WAIT_L(0); PG8_BAR; PG8_MMA(1, 0, At, B0); PG8_MMA(1, 1, At, B1); PG8_BAR; PG8_SCHED;
        }
        if (wr == 0) PG8_BAR;
        { int l2 = lane; asm volatile("" : "+v"(l2)); E(acc, cur, wr, wc, l2 & 15, l2 >> 4); }
        if (!has_next) break;
#pragma unroll
        for (int a = 0; a < 2; ++a)
#pragma unroll
            for (int b = 0; b < 2; ++b)
#pragma unroll
                for (int m = 0; m < 4; ++m)
#pragma unroll
                    for (int n = 0; n < 2; ++n) acc[a][b][m][n] = (f32x4){0.f, 0.f, 0.f, 0.f};
        cur = nxt; cA = nA; cB = nB; ++ui;
        if (wr == 1) PG8_BAR;
    }
    PG8_WAIT_V(0);
    PG8_BAR;
#undef PG8_SA
#undef PG8_SB
#undef PG8_STAGE
#undef PG8_LDA
#undef PG8_LDB
#undef PG8_MMA
#undef PG8_WAIT_V
#undef PG8_WAIT_L
#undef PG8_BAR
#undef PG8_SCHED
}
}

#define MFMA32(a, b, c) __builtin_amdgcn_mfma_f32_32x32x16_bf16(a, b, c, 0, 0, 0)
typedef short v4i16_t __attribute__((ext_vector_type(4)));
__device__ __forceinline__ s16x4 vtr(const LAS unsigned char* p) { return __builtin_bit_cast(s16x4, __builtin_amdgcn_ds_read_tr16_b64_v4i16((LAS v4i16_t*)p)); }

template <int ND, class Spec>
__device__ __forceinline__ void attn_scores(const bf16x8 (&q)[ND], const LAS unsigned char* kb, const int kstride,
                                            f32x16 (&o)[2], float& m, float& l, const Spec& sp, const int t, LAS float* wsf, const int lane, u32x4 (&pw)[4]) {
    const int r32 = lane & 31, hi = lane >> 5;
    f32x16 p0, p1;
    const f32x16 z16 = (f32x16){0.f, 0.f, 0.f, 0.f, 0.f, 0.f, 0.f, 0.f, 0.f, 0.f, 0.f, 0.f, 0.f, 0.f, 0.f, 0.f};
    const LAS unsigned char* kp = kb + r32 * kstride + hi * 16;
#pragma unroll
    for (int d0 = 0; d0 < ND; ++d0) {
        const bf16x8 k0 = *(const LAS bf16x8*)(kp + d0 * 32);
        const bf16x8 k1 = *(const LAS bf16x8*)(kp + 32 * kstride + d0 * 32);
        if (d0 == 0) { p0 = MFMA32(k0, q[d0], z16); p1 = MFMA32(k1, q[d0], z16); }
        else { p0 = MFMA32(k0, q[d0], p0); p1 = MFMA32(k1, q[d0], p1); }
    }
    { const auto cx = sp.prep(t, r32, hi);
#pragma unroll
      for (int r = 0; r < 16; ++r) { p0[r] = sp.mask(p0[r], cx, r, 0); p1[r] = sp.mask(p1[r], cx, r, 1); } }
    float rm = max3f(p0[0], p0[1], p1[0]), rb = max3f(p0[2], p0[3], p1[1]); rm = max3f(rm, p1[2], p1[3]);
#pragma unroll
    for (int r = 4; r < 16; r += 4) { rm = max3f(rm, p0[r], p0[r + 1]); rb = max3f(rb, p0[r + 2], p0[r + 3]); rm = max3f(rm, p1[r], p1[r + 1]); rb = max3f(rb, p1[r + 2], p1[r + 3]); }
    rm = half_max(fmaxf(rm, rb)) * Spec::SC;
    const float mnew = fmaxf(m, rm);
    if (__any(mnew > m)) {
        const float mref = (mnew == -INFINITY) ? 0.f : mnew;
        const float alpha = __builtin_amdgcn_exp2f(m - mref);
        l *= alpha; m = mnew;
        if (hi == 0) wsf[r32] = alpha;
#pragma unroll
        for (int r = 0; r < 16; ++r) { const float a = wsf[crow(r, hi)]; o[0][r] *= a; o[1][r] *= a; }
    }
    const float mref = (m == -INFINITY) ? 0.f : m;
    float ls = 0.f;
#pragma unroll
    for (int r = 0; r < 16; ++r) { p0[r] = __builtin_amdgcn_exp2f(__builtin_fmaf(p0[r], Spec::SC, -mref)); p1[r] = __builtin_amdgcn_exp2f(__builtin_fmaf(p1[r], Spec::SC, -mref)); ls += p0[r] + p1[r]; }
    l += ls;
#pragma unroll
    for (int j = 0; j < 4; ++j) { pw[0][j] = cvt_pk_bf16(p0[2 * j], p0[2 * j + 1]); pw[1][j] = cvt_pk_bf16(p0[8 + 2 * j], p0[8 + 2 * j + 1]);
                                  pw[2][j] = cvt_pk_bf16(p1[2 * j], p1[2 * j + 1]); pw[3][j] = cvt_pk_bf16(p1[8 + 2 * j], p1[8 + 2 * j + 1]); }
}
__device__ __forceinline__ void attn_pv(const u32x4 (&pw)[4], const LAS unsigned char* vb, f32x16 (&o)[2], const int lane, const int vhs = 4096) {
    const int hi = lane >> 5;
    const LAS unsigned char* vp = vb + ((lane >> 4) & 1) * 32 + (lane & 3) * 8 + (4 * hi + ((lane & 15) >> 2)) * 64;
    s16x4 lo[2][4], hh[2][4];
#pragma unroll
    for (int ks = 0; ks < 4; ++ks)
#pragma unroll
        for (int d0 = 0; d0 < 2; ++d0) { lo[d0][ks] = vtr(vp + d0 * vhs + ks * 1024); hh[d0][ks] = vtr(vp + d0 * vhs + ks * 1024 + 512); }
#pragma unroll
    for (int ks = 0; ks < 4; ++ks)
#pragma unroll
        for (int d0 = 0; d0 < 2; ++d0) {
            const bf16x8 vf = (bf16x8){lo[d0][ks][0], lo[d0][ks][1], lo[d0][ks][2], lo[d0][ks][3], hh[d0][ks][0], hh[d0][ks][1], hh[d0][ks][2], hh[d0][ks][3]};
            o[d0] = MFMA32(__builtin_bit_cast(bf16x8, pw[ks]), vf, o[d0]);
        }
}

#define PIN16(x) asm volatile("" : "+v"(x))
template <int ND, bool HAS_NEXT>
__device__ __forceinline__ void dense_step(const bf16x8 (&q)[ND], const LAS unsigned char* kbn, const int kstride, const LAS unsigned char* vb,
                                           f32x16& PA0, f32x16& PA1, f32x16& PB0, f32x16& PB1, f32x16 (&o)[2], float& m, float& l, const float SC, LAS float* wsf, const int lane) {
    const int r32 = lane & 31, hi = lane >> 5;
    float rm = max3f(PA0[0], PA0[1], PA1[0]), rb = max3f(PA0[2], PA0[3], PA1[1]); rm = max3f(rm, PA1[2], PA1[3]);
#pragma unroll
    for (int r = 4; r < 16; r += 4) { rm = max3f(rm, PA0[r], PA0[r + 1]); rb = max3f(rb, PA0[r + 2], PA0[r + 3]); rm = max3f(rm, PA1[r], PA1[r + 1]); rb = max3f(rb, PA1[r + 2], PA1[r + 3]); }
    rm = half_max(fmaxf(rm, rb)) * SC;
    const float mnew = fmaxf(m, rm);
    if (__any(mnew > m)) {
        const float alpha = __builtin_amdgcn_exp2f(m - mnew);
        l *= alpha; m = mnew;
        if (hi == 0) wsf[r32] = alpha;
#pragma unroll
        for (int r = 0; r < 16; ++r) { const float a = wsf[crow(r, hi)]; o[0][r] *= a; o[1][r] *= a; }
    }
    const float nm = -m;
    __builtin_amdgcn_sched_barrier(0);
    const LAS unsigned char* kp = kbn + r32 * kstride + hi * 16;
    float ls = 0.f;
    constexpr int NM = 2 * ND;
    const f32x16 z16 = (f32x16){0.f, 0.f, 0.f, 0.f, 0.f, 0.f, 0.f, 0.f, 0.f, 0.f, 0.f, 0.f, 0.f, 0.f, 0.f, 0.f};
    bf16x8 kfr[3] = {q[0], q[0], q[0]};
    if constexpr (HAS_NEXT) {
#pragma unroll
        for (int i = 0; i < 3; ++i) kfr[i] = *(const LAS bf16x8*)(kp + (i & 1) * 32 * kstride + (i >> 1) * 32);
    }
#pragma unroll
    for (int i = 0; i < NM; ++i) {
        if constexpr (HAS_NEXT) {
            const int d0 = i >> 1;
            const bf16x8 kf = kfr[i % 3];
            if (i & 1) PB1 = (d0 == 0) ? MFMA32(kf, q[d0], z16) : MFMA32(kf, q[d0], PB1);
            else       PB0 = (d0 == 0) ? MFMA32(kf, q[d0], z16) : MFMA32(kf, q[d0], PB0);
            if (i + 3 < NM) kfr[i % 3] = *(const LAS bf16x8*)(kp + ((i + 3) & 1) * 32 * kstride + ((i + 3) >> 1) * 32);
        }
#pragma unroll
        for (int e = (32 * i) / NM; e < (32 * (i + 1)) / NM; ++e) {
            if (e < 16) { PA0[e] = __builtin_amdgcn_exp2f(__builtin_fmaf(PA0[e], SC, nm)); ls += PA0[e]; }
            else { PA1[e - 16] = __builtin_amdgcn_exp2f(__builtin_fmaf(PA1[e - 16], SC, nm)); ls += PA1[e - 16]; }
        }
        PIN16(PA0); PIN16(PA1); PIN16(ls);
        __builtin_amdgcn_sched_barrier(0);
    }
    l += ls;
    u32x4 pw[4];
#pragma unroll
    for (int j = 0; j < 4; ++j) { pw[0][j] = cvt_pk_bf16(PA0[2 * j], PA0[2 * j + 1]); pw[1][j] = cvt_pk_bf16(PA0[8 + 2 * j], PA0[8 + 2 * j + 1]);
                                  pw[2][j] = cvt_pk_bf16(PA1[2 * j], PA1[2 * j + 1]); pw[3][j] = cvt_pk_bf16(PA1[8 + 2 * j], PA1[8 + 2 * j + 1]); }
    attn_pv(pw, vb, o, lane);
}

template <class Spec>
__device__ __forceinline__ float attn_finish(f32x16 (&o)[2], const float l, const Spec& sp, LAS float* wsf, LAS bf16_t* stg, const int lane) {
    const int r32 = lane & 31, hi = lane >> 5;
    const float lt = half_sum(l);
    if (hi == 0) wsf[32 + r32] = lt;
#pragma unroll
    for (int r = 0; r < 16; ++r) { const int orow = crow(r, hi); const float rl = 1.0f / wsf[32 + orow];
        const unsigned w = cvt_pk_bf16(o[0][r] * rl, o[1][r] * rl);
        stg[orow * 64 + r32] = (bf16_t)(w & 0xffffu); stg[orow * 64 + 32 + r32] = (bf16_t)(w >> 16); }
#pragma unroll
    for (int i = 0; i < 4; ++i) { const int row = i * 8 + (lane >> 3), ch = lane & 7; *(u32x4*)(sp.orow(row) + ch * 8) = *(const LAS u32x4*)(stg + row * 64 + ch * 8); }
    return lt;
}

constexpr int AW_K = 0, AW_KSTRIDE = 144, AW_V = 9216, AW_WSF = 17408, AW_BIAS = 17664, AW_BYTES = 19712;
static_assert(AW_BYTES * NWAVES <= LDS_BYTES, "attention LDS");

template <class Spec>
__device__ __forceinline__ void attn_wave_item(const Spec& sp, LAS unsigned char* wl, const int lane, float m0, float l0) {
    const int r32 = lane & 31, hi = lane >> 5;
    LAS float* wsf = (LAS float*)(wl + AW_WSF);
    bf16x8 q[4];
    { const bf16_t* qp = sp.qrow(r32);
#pragma unroll
      for (int d0 = 0; d0 < 4; ++d0) q[d0] = *(const bf16x8*)(qp + d0 * 16 + hi * 8); }
    f32x16 o[2];
#pragma unroll
    for (int r = 0; r < 16; ++r) { o[0][r] = 0.f; o[1][r] = 0.f; }
    float m = m0, l = (hi == 0) ? l0 : 0.f;
    int tlo = 0, thi = Spec::NT;
    while (tlo < thi && sp.skip(tlo)) ++tlo;
    while (thi > tlo && sp.skip(thi - 1)) --thi;
    const int lrow = lane >> 3, lc = lane & 7;
    u32x4 kr[8];
#pragma unroll
    for (int j = 0; j < 8; ++j) kr[j] = *(const u32x4*)(sp.kptr(sp.ktok(tlo, j * 8 + lrow)) + lc * 8);
    LAS unsigned char* kw = wl + AW_K + lrow * AW_KSTRIDE + lc * 16; LAS unsigned char* vw = wl + AW_V + (lc >> 2) * 4096 + lrow * 64 + (lc & 3) * 16;
    for (int t = tlo; t < thi; ++t) {
#pragma unroll
        for (int j = 0; j < 8; ++j) *(LAS u32x4*)(kw + j * 8 * AW_KSTRIDE) = kr[j];
#pragma unroll
        for (int j = 0; j < 8; ++j) kr[j] = *(const u32x4*)(sp.vptr(sp.ktok(t, j * 8 + lrow)) + lc * 8);
        u32x4 pw[4];
        attn_scores<4, Spec>(q, wl + AW_K, AW_KSTRIDE, o, m, l, sp, t, wsf, lane, pw);
#pragma unroll
        for (int j = 0; j < 8; ++j) *(LAS u32x4*)(vw + j * 8 * 64) = kr[j];
        if (t + 1 < thi) {
#pragma unroll
            for (int j = 0; j < 8; ++j) kr[j] = *(const u32x4*)(sp.kptr(sp.ktok(t + 1, j * 8 + lrow)) + lc * 8);
        }
        attn_pv(pw, wl + AW_V, o, lane);
    }
    const float lt = attn_finish(o, l, sp, wsf, (LAS bf16_t*)(wl + AW_K), lane);
    sp.finish(m, lt, r32, hi);
}

struct DilSpec {
    static constexpr int NT = 3;
    const bf16_t* proj; const bf16_t* kc; bf16_t* oc; float* lse; int b, r, d, sd, ci0, h, kstart;
    __device__ __forceinline__ const bf16_t* qrow(int row) const { return proj + (size_t)(b * SEQ + (ci0 + row) * d + r) * EVEN_IN + h * 64; }
    __device__ __forceinline__ bool skip(int t) const { const int k0 = kstart + 64 * t; return (k0 + 63 < 0) || (k0 >= sd); }
    __device__ __forceinline__ size_t ktok(int t, int kk) const { const int kj = clampi(kstart + 64 * t + kk, 0, sd - 1), tk = kj * d + r; return (size_t)(b * SEQ + ((tk & 15) << 8) + (tk >> 4)); }
    __device__ __forceinline__ const bf16_t* kptr(size_t row) const { return kc + row * 1024 + h * 64; }
    __device__ __forceinline__ const bf16_t* vptr(size_t row) const { return kc + row * 1024 + 512 + h * 64; }
    static constexpr float SC = 0.125f * LOG2E;
    struct Cx { int a; unsigned w; };
    __device__ __forceinline__ Cx prep(int t, int r32, int hi) const { const int qi = ci0 + r32, lo = qi - 64 > 0 ? qi - 64 : 0, hi_ = qi + 64 < sd - 1 ? qi + 64 : sd - 1; return Cx{kstart + 64 * t + 4 * hi - lo, (unsigned)(hi_ - lo)}; }
    __device__ __forceinline__ float mask(float s, const Cx& cx, int r, int half) const { return ((unsigned)(cx.a + ((r & 3) + 8 * (r >> 2) + 32 * half)) <= cx.w) ? s : -INFINITY; }
    __device__ __forceinline__ bf16_t* orow(int row) const { return oc + (size_t)(b * SEQ + (ci0 + row) * d + r) * 512 + h * 64; }
    __device__ __forceinline__ void finish(float m, float lt, int r32, int hi) const { if (hi == 0) lse[(size_t)(b * SEQ + (ci0 + r32) * d + r) * 8 + h] = m * LN2 + __logf(lt); }
};
struct NaSpec {
    static constexpr int NT = 5;
    const bf16_t* proj; bf16_t* mixed; const LAS float* bias; int b, gr, hf, h, rs, cb;
    __device__ __forceinline__ const bf16_t* qrow(int row) const { return proj + (size_t)(b * SEQ + gr * 64 + 32 * hf + row) * EVEN_IN + 1536 + h * 64; }
    __device__ __forceinline__ bool skip(int) const { return false; }
    __device__ __forceinline__ size_t ktok(int t, int kk) const { return (size_t)(b * SEQ + (rs + (kk >> 3)) * 64 + cb + 8 * t + (kk & 7)); }
    __device__ __forceinline__ const bf16_t* kptr(size_t tok) const { return proj + tok * EVEN_IN + 2048 + h * 64; }
    __device__ __forceinline__ const bf16_t* vptr(size_t tok) const { return proj + tok * EVEN_IN + 2560 + h * 64; }
    static constexpr float SC = 0.125f * LOG2E;
    struct Cx { const LAS float* bp[4]; bool v[4]; };
    __device__ __forceinline__ Cx prep(int t, int r32, int hi) const { Cx c; const int qcol = 32 * hf + r32, ws = clampi(qcol - 8, 0, 48);
#pragma unroll
        for (int j = 0; j < 4; ++j) { const int kcol = cb + 8 * t + j + 4 * hi; c.v[j] = (kcol >= ws) && (kcol < ws + 16); c.bp[j] = bias + (rs - gr + 7) * 31 + clampi(kcol - qcol + 15, 0, 30); }
        return c; }
    __device__ __forceinline__ float mask(float s, const Cx& cx, int r, int half) const { return cx.v[r & 3] ? s + cx.bp[r & 3][31 * ((r >> 2) + 4 * half)] : -INFINITY; }
    __device__ __forceinline__ bf16_t* orow(int row) const { return mixed + (size_t)(b * SEQ + gr * 64 + 32 * hf + row) * DM + 512 + h * 64; }
    __device__ __forceinline__ void finish(float, float, int, int) const {}
};
struct SwaSpec {
    static constexpr int NT = 5;
    const bf16_t* proj; bf16_t* mixed; int b, hq, kvh, q0, kstart;
    __device__ __forceinline__ const bf16_t* qrow(int row) const { return proj + (size_t)(b * SEQ + q0 + row) * ODD_INP + hq * 64; }
    __device__ __forceinline__ bool skip(int t) const { const int k0 = kstart + 64 * t; return (k0 + 63 < 0) || (k0 >= SEQ); }
    __device__ __forceinline__ size_t ktok(int t, int kk) const { return (size_t)(b * SEQ + clampi(kstart + 64 * t + kk, 0, SEQ - 1)); }
    __device__ __forceinline__ const bf16_t* kptr(size_t tok) const { return proj + tok * ODD_INP + 512 + kvh * 64; }
    __device__ __forceinline__ const bf16_t* vptr(size_t tok) const { return proj + tok * ODD_INP + 640 + kvh * 64; }
    static constexpr float SC = 0.125f * LOG2E;
    struct Cx { int a; unsigned w; };
    __device__ __forceinline__ Cx prep(int t, int r32, int hi) const { const int qi = q0 + r32, lo = qi - 128 > 0 ? qi - 128 : 0, hi_ = qi + 128 < SEQ - 1 ? qi + 128 : SEQ - 1; return Cx{kstart + 64 * t + 4 * hi - lo, (unsigned)(hi_ - lo)}; }
    __device__ __forceinline__ float mask(float s, const Cx& cx, int r, int half) const { return ((unsigned)(cx.a + ((r & 3) + 8 * (r >> 2) + 32 * half)) <= cx.w) ? s : -INFINITY; }
    __device__ __forceinline__ bf16_t* orow(int row) const { return mixed + (size_t)(b * SEQ + q0 + row) * DM + hq * 64; }
    __device__ __forceinline__ void finish(float, float, int, int) const {}
};
struct MlaSpec {
    static constexpr float SC = 0.10206207261596577f * LOG2E;
    bf16_t* mixed; int tok0, h;
    __device__ __forceinline__ bf16_t* orow(int row) const { return mixed + (size_t)(tok0 + row) * DM + 512 + h * 64; }
};
constexpr int ML_K0 = 0, ML_KSTRIDE = 208, ML_KB = 13312, ML_V0 = 3 * ML_KB, ML_VB = 8192, ML_WSF = ML_V0 + 3 * ML_VB,
              ML_STG = ML_WSF + NWAVES * 256, ML_BYTES = ML_STG + NWAVES * 4096;
static_assert(ML_BYTES <= LDS_BYTES, "mla LDS");

#define XB_TMO      128
#define XB_XCNT(j)  (256  + 64 * (j))
#define XB_XSUB(j)  (1280 + 64 * (j))
#define XB_XGEN(j)  (2304 + 64 * (j))
#define XB_TOP      3328
#define XB_TOPGEN   3392
#define XCD_BAR_WORDS 3456
#define XB_SPIN_CAP (1u << 18)

__device__ __forceinline__ unsigned xb_ld(unsigned* p)              { return __hip_atomic_load(p, __ATOMIC_RELAXED, __HIP_MEMORY_SCOPE_AGENT); }
__device__ __forceinline__ unsigned xb_add(unsigned* p, unsigned v) { return __hip_atomic_fetch_add(p, v, __ATOMIC_RELAXED, __HIP_MEMORY_SCOPE_AGENT); }
__device__ __forceinline__ unsigned xb_xcc_id() { return (unsigned)__builtin_amdgcn_s_getreg((3 << 11) | 20) & 0xFu; }
#define XB_SPIN(cond, bar) do { unsigned _sp = 0; while (cond) { __builtin_amdgcn_s_sleep(1); \
    if ((++_sp & 255u) == 0u) { if (xb_ld(&(bar)[XB_TMO])) break; if (_sp > XB_SPIN_CAP) { atomicAdd(&(bar)[XB_TMO], 1u); break; } } } } while (0)

struct XcdBarrier {
    unsigned* bar; unsigned x;
    volatile LAS unsigned* st;
};

__device__ __forceinline__ XcdBarrier xcd_barrier_post(unsigned* bar, volatile LAS unsigned* st) {
    XcdBarrier b; b.bar = bar; b.x = xb_xcc_id(); b.st = st;
    if (threadIdx.x == 0) (void)xb_add(&bar[XB_XCNT(b.x)], 1u);
    return b;
}
__device__ __forceinline__ void xcd_barrier_complete(unsigned* bar, unsigned x, unsigned& nloc, unsigned& nx) {
    const unsigned G = gridDim.x * gridDim.y * gridDim.z;
    unsigned sum, cnt, mine, sp = 0u;
    for (;;) {
        sum = 0u; cnt = 0u; mine = 0u;
#pragma unroll
        for (unsigned j = 0; j < 16; ++j) { const unsigned c = xb_ld(&bar[XB_XCNT(j)]); sum += c; cnt += (c > 0u) ? 1u : 0u; mine = (j == x) ? c : mine; }
        if (sum == G) break;
        __builtin_amdgcn_s_sleep(1);
        if ((++sp & 255u) == 0u) { if (xb_ld(&bar[XB_TMO])) break; if (sp > XB_SPIN_CAP) { atomicAdd(&bar[XB_TMO], 1u); break; } }
    }
    nloc = mine > 0u ? mine : 1u; nx = cnt > 0u ? cnt : 1u;
}

__device__ __forceinline__ void xcd_barrier(const XcdBarrier& b) {
    asm volatile("s_waitcnt vmcnt(0)" ::: "memory");
    __syncthreads();
    if (threadIdx.x == 0) {
        unsigned* bar = b.bar;
        __builtin_amdgcn_s_waitcnt(0);
        unsigned nloc = b.st[0], nx = b.st[1];
        if (nloc == 0u) { xcd_barrier_complete(bar, b.x, nloc, nx); b.st[0] = nloc; b.st[1] = nx; }
        const unsigned old = xb_add(&bar[XB_XSUB(b.x)], 1u);
        const unsigned gen = old / nloc;
        if (old + 1u == (gen + 1u) * nloc) {
            __builtin_amdgcn_fence(__ATOMIC_RELEASE, "agent");
            __builtin_amdgcn_fence(__ATOMIC_ACQUIRE, "agent");
            asm volatile("s_waitcnt vmcnt(0)" ::: "memory");
            const unsigned og = xb_add(&bar[XB_TOP], 1u);
            const unsigned tg = og / nx;
            if (og + 1u == (tg + 1u) * nx) xb_add(&bar[XB_TOPGEN], 1u);
            else XB_SPIN(xb_ld(&bar[XB_TOPGEN]) == tg, bar);
            asm volatile("s_waitcnt vmcnt(0)" ::: "memory");
        } else {
            __builtin_amdgcn_fence(__ATOMIC_ACQUIRE, "agent");
            XB_SPIN(xb_ld(&bar[XB_TOPGEN]) == gen, bar);
            asm volatile("s_waitcnt vmcnt(0)" ::: "memory");
        }
    }
    __syncthreads();
}

struct Args {
    const float* in[21];
    float* out; unsigned char* ws;
    int ph_lo, ph_hi;
};
typedef const __attribute__((address_space(4))) Args CArgs;
enum { I_X = 0, I_F1N, I_F1W1, I_F1W3, I_F1W2, I_MIXN, I_F2N, I_F2W1, I_F2W3, I_F2W2, I_EWIN, I_EWOUT, I_RPB, I_OWIN, I_OWOUT, I_SINK, I_QN, I_WQB, I_KVN, I_WKVB, I_FN };

__device__ __forceinline__ void rmsnorm_rows(const float* h, const float* g, bf16_t* hn, int gw, int NGW, int lane) {
    f32x4 gv[4];
#pragma unroll
    for (int j = 0; j < 4; ++j) gv[j] = ((const f32x4*)g)[lane + 64 * j];
    for (int row = gw; row < T; row += NGW) {
        const f32x4* xr = (const f32x4*)(h + (size_t)row * DM) + lane;
        f32x4 v[4]; float s = 0.f;
#pragma unroll
        for (int j = 0; j < 4; ++j) { v[j] = xr[64 * j]; s += (v[j].x * v[j].x + v[j].y * v[j].y) + (v[j].z * v[j].z + v[j].w * v[j].w); }
        const float rstd = 1.0f / sqrtf(wave_sum(s) * (1.0f / DM) + NORM_EPS);
        u32x2* o8 = (u32x2*)(hn + (size_t)row * DM) + lane;
#pragma unroll
        for (int j = 0; j < 4; ++j) { const f32x4 y = v[j] * rstd * gv[j]; u32x2 w; w.x = cvt_pk_bf16(y.x, y.y); w.y = cvt_pk_bf16(y.z, y.w); o8[64 * j] = w; }
    }
}
__device__ __forceinline__ void load_row_bf16(const bf16_t* hrow, int lane, float (&x)[16]) {
    const u32x4 a = ((const u32x4*)hrow)[lane], b = ((const u32x4*)hrow)[64 + lane];
#pragma unroll
    for (int j = 0; j < 4; ++j) { x[2 * j] = f16_lo(a[j]); x[2 * j + 1] = f16_hi(a[j]); x[8 + 2 * j] = f16_lo(b[j]); x[8 + 2 * j + 1] = f16_hi(b[j]); }
}
__device__ __forceinline__ void rmsnorm_rows_bf16(const bf16_t* h, const float* g, bf16_t* hn, int gw, int NGW, int lane) {
    float gv[16];
#pragma unroll
    for (int j = 0; j < 8; ++j) { gv[j] = g[lane * 8 + j]; gv[8 + j] = g[512 + lane * 8 + j]; }
    for (int row = gw; row < T; row += NGW) {
        float x[16]; load_row_bf16(h + (size_t)row * DM, lane, x);
        float s = 0.f;
#pragma unroll
        for (int j = 0; j < 16; ++j) s += x[j] * x[j];
        const float rstd = 1.0f / sqrtf(wave_sum(s) * (1.0f / DM) + NORM_EPS);
        u32x4 a, b;
#pragma unroll
        for (int j = 0; j < 4; ++j) { a[j] = cvt_pk_bf16(x[2 * j] * rstd * gv[2 * j], x[2 * j + 1] * rstd * gv[2 * j + 1]); b[j] = cvt_pk_bf16(x[8 + 2 * j] * rstd * gv[8 + 2 * j], x[8 + 2 * j + 1] * rstd * gv[8 + 2 * j + 1]); }
        ((u32x4*)(hn + (size_t)row * DM))[lane] = a; ((u32x4*)(hn + (size_t)row * DM))[64 + lane] = b;
    }
}
__device__ __forceinline__ void final_norm_rows(const bf16_t* h, float* out, const float* g, int gw, int NGW, int lane) {
    float gv[16];
#pragma unroll
    for (int j = 0; j < 8; ++j) { gv[j] = g[lane * 8 + j]; gv[8 + j] = g[512 + lane * 8 + j]; }
    for (int row = gw; row < T; row += NGW) {
        float x[16]; load_row_bf16(h + (size_t)row * DM, lane, x);
        float s = 0.f;
#pragma unroll
        for (int j = 0; j < 16; ++j) s += x[j] * x[j];
        const float rstd = 1.0f / sqrtf(wave_sum(s) * (1.0f / DM) + NORM_EPS);
        float* orow = out + (size_t)row * DM;
#pragma unroll
        for (int j = 0; j < 2; ++j) {
            *(f32x4*)(orow + lane * 8 + 4 * j) = (f32x4){x[4 * j] * rstd * gv[4 * j], x[4 * j + 1] * rstd * gv[4 * j + 1], x[4 * j + 2] * rstd * gv[4 * j + 2], x[4 * j + 3] * rstd * gv[4 * j + 3]};
            *(f32x4*)(orow + 512 + lane * 8 + 4 * j) = (f32x4){x[8 + 4 * j] * rstd * gv[8 + 4 * j], x[8 + 4 * j + 1] * rstd * gv[8 + 4 * j + 1], x[8 + 4 * j + 2] * rstd * gv[8 + 4 * j + 2], x[8 + 4 * j + 3] * rstd * gv[8 + 4 * j + 3]}; }
    }
}
__device__ __forceinline__ void transpose_item(const float* W, int srcN, int k0, int sc0, bf16_t* WT, int K, int dr0, LAS float* scr, int lane) {
#pragma unroll 8
    for (int i = 0; i < 32; ++i) { const int kk = 2 * i + (lane >> 5); scr[kk * 33 + (lane & 31)] = W[(size_t)(k0 + kk) * srcN + sc0 + (lane & 31)]; }
    asm volatile("s_waitcnt lgkmcnt(0)" ::: "memory");
    const int c = lane & 7;
#pragma unroll
    for (int j = 0; j < 4; ++j) { const int n = (lane >> 3) + 8 * j; const LAS float* s = scr + (8 * c) * 33 + n;
        u32x4 o; o.x = cvt_pk_bf16(s[0 * 33], s[1 * 33]); o.y = cvt_pk_bf16(s[2 * 33], s[3 * 33]); o.z = cvt_pk_bf16(s[4 * 33], s[5 * 33]); o.w = cvt_pk_bf16(s[6 * 33], s[7 * 33]);
        *(u32x4*)(WT + (size_t)(dr0 + n) * K + k0 + 8 * c) = o; }
    asm volatile("s_waitcnt lgkmcnt(0)" ::: "memory");
}
__device__ __forceinline__ void tr_plain(const float* W, int K, int N, bf16_t* WT, int item, LAS float* scr, int lane) {
    const int nblk = N / 32, kb = item / nblk, nb = item % nblk;
    transpose_item(W, N, 64 * kb, 32 * nb, WT, K, 32 * nb, scr, lane);
}
__device__ __forceinline__ void tr_up(const float* w1, const float* w3, bf16_t* WT, int item, LAS float* scr, int lane) {
    constexpr int nrb = 2 * FF / 32; const int kb = item / nrb, rb = item % nrb, pn = rb >> 3, within = rb & 7, half = within >> 2, sub = within & 3;
    transpose_item(half ? w3 : w1, FF, 64 * kb, pn * 128 + sub * 32, WT, DM, 32 * rb, scr, lane);
}

__device__ __forceinline__ void sincos_d(double a, double& s, double& c) {
    const double k = rint(a * 0.63661977236758134308);
    double r = fma(-k, 1.57079632679489655800e+00, a); r = fma(-k, 6.12323399573676603587e-17, r);
    const double r2 = r * r;
    double sp = 1.0 / 6227020800.0; sp = fma(sp, r2, -1.0 / 39916800.0); sp = fma(sp, r2, 1.0 / 362880.0); sp = fma(sp, r2, -1.0 / 5040.0); sp = fma(sp, r2, 1.0 / 120.0); sp = fma(sp, r2, -1.0 / 6.0);
    const double sr = fma(sp * r2, r, r);
    double cp = -1.0 / 87178291200.0; cp = fma(cp, r2, 1.0 / 479001600.0); cp = fma(cp, r2, -1.0 / 3628800.0); cp = fma(cp, r2, 1.0 / 40320.0); cp = fma(cp, r2, -1.0 / 720.0); cp = fma(cp, r2, 1.0 / 24.0); cp = fma(cp, r2, -0.5);
    const double cr = fma(cp, r2, 1.0);
    const int qd = ((int)k) & 3;
    s = (qd == 0) ? sr : (qd == 1) ? cr : (qd == 2) ? -sr : -cr;
    c = (qd == 0) ? cr : (qd == 1) ? -sr : (qd == 2) ? -cr : sr;
}

__device__ __forceinline__ void rope8(u32x4& a, u32x4& b, const float* cs, const float* sn, int st) {
    u32x4 ra, rb;
#pragma unroll
    for (int j = 0; j < 4; ++j) {
        const float x1l = bf_lo(a[j]), x1h = bf_hi(a[j]), x2l = bf_lo(b[j]), x2h = bf_hi(b[j]);
        const float cl = cs[(2 * j) * st], ch = cs[(2 * j + 1) * st], sl = sn[(2 * j) * st], sh = sn[(2 * j + 1) * st];
        ra[j] = cvt_pk_bf16(x1l * cl - x2l * sl, x1h * ch - x2h * sh);
        rb[j] = cvt_pk_bf16(x2l * cl + x1l * sl, x2h * ch + x1h * sh);
    }
    a = ra; b = rb;
}

__device__ __forceinline__ void rope8_fly(u32x4& a, u32x4& b, const float pos, const int i0) {
    u32x4 ra, rb;
#pragma unroll
    for (int j = 0; j < 4; ++j) {
        float cs[2], sn[2];
#pragma unroll
        for (int e = 0; e < 2; ++e) { const float rev = __builtin_amdgcn_fractf(pos * (__builtin_amdgcn_exp2f((float)(i0 + 2 * j + e) * (-13.287712379549449f / 32.0f)) * 0.15915494309189535f));
            sn[e] = __builtin_amdgcn_sinf(rev); cs[e] = __builtin_amdgcn_cosf(rev); }
        const float x1l = bf_lo(a[j]), x1h = bf_hi(a[j]), x2l = bf_lo(b[j]), x2h = bf_hi(b[j]);
        ra[j] = cvt_pk_bf16(x1l * cs[0] - x2l * sn[0], x1h * cs[1] - x2h * sn[1]);
        rb[j] = cvt_pk_bf16(x2l * cs[0] + x1l * sn[0], x2h * cs[1] + x1h * sn[1]);
    }
    a = ra; b = rb;
}

__global__ void __launch_bounds__(NTHREADS, 2) fwd_megakernel(Args args) {
    extern __shared__ __attribute__((aligned(16))) unsigned char lds_raw[];
    LAS unsigned char* lds = (LAS unsigned char*)lds_raw;
    cg::grid_group grid = cg::this_grid();
    const int G = gridDim.x, NGW = G * NWAVES;
    unsigned char* ws0 = args.ws;
    volatile LAS unsigned* bst = (volatile LAS unsigned*)(lds + LDS_BYTES - 64);
    if (threadIdx.x < 16) bst[threadIdx.x] = 0u;
    __syncthreads();
    const XcdBarrier xbar = xcd_barrier_post((unsigned*)(ws0 + WS_BAR), bst);

    if (args.ph_lo == 0) {
        float* cosT = (float*)(ws0 + WS_COS); float* sinT = (float*)(ws0 + WS_SIN);
        for (int e = blockIdx.x * NTHREADS + threadIdx.x; e < SEQ * 32; e += G * NTHREADS) {
            const int pos = e >> 5, i = e & 31; double s, c; sincos_d((double)pos * exp2((double)i * (-13.287712379549449 / 32.0)), s, c); cosT[e] = (float)c; sinT[e] = (float)s; }
    }
#ifndef PROBE_DUP
#define PROBE_DUP 0
#endif
    bool dup_done = false; (void)dup_done;
    for (int ph = args.ph_lo; ph < args.ph_hi; ++ph) {
        int tid = threadIdx.x; asm volatile("" : "+v"(tid));
        int bid = blockIdx.x; asm volatile("" : "+s"(bid));
        const CArgs* ap = (const CArgs*)__builtin_amdgcn_kernarg_segment_ptr(); asm volatile("" : "+s"(ap));
        const int lane = tid & 63, wave = __builtin_amdgcn_readfirstlane(tid >> 6), gw = bid * NWAVES + wave;
        unsigned char* ws = ap->ws; float* hres = ap->out;
        float* cosT = (float*)(ws + WS_COS); float* sinT = (float*)(ws + WS_SIN);
        bf16_t* hn = (bf16_t*)(ws + WS_HN); bf16_t* mixed = hn;
        bf16_t* hbf = (bf16_t*)(ws + WS_NAO);
        bf16_t* big = (bf16_t*)(ws + WS_BIG);
        bf16_t* oc = (bf16_t*)(ws + WS_AUX); float* lse = (float*)(ws + WS_AUX + AUX_LSE);
        bf16_t* qmla = (bf16_t*)(ws + WS_AUX); bf16_t* kvmla = (bf16_t*)(ws + WS_AUX + AUX_KV);
        const int li = ph / 12, st = ph % 12, jj = li >> 1; const bool even = (li & 1) == 0;
        if (ph < DEPTH * 12 && even && st == 5) continue;
        if (ph == DEPTH * 12) {
            final_norm_rows(hbf, hres, ap->in[I_FN], gw, NGW, lane);
        } else if (st == 0) {
            LAS float* scr = (LAS float*)(lds + wave * 8448);
            constexpr int I_UP = (DM / 64) * (2 * FF / 32), I_DN = (FF / 64) * (DM / 32), I_EIN = (DM / 64) * (EVEN_IN / 32), I_OIN = (DM / 64) * (ODD_IN / 32), I_OUT = (DM / 64) * (DM / 32),
                          I_QBI = (384 / 64) * (768 / 32), I_KVBI = (256 / 64) * (1024 / 32), I_PAD = ODD_INP - ODD_IN;
            const int n_in = even ? I_EIN : I_OIN;
            const int total = 2 * I_UP + 2 * I_DN + n_in + I_OUT + (even ? 0 : (I_QBI + I_KVBI + I_PAD));
            const size_t wff = (size_t)li * DM * FF;
            for (int it = gw; it < total; it += NGW) {
                int r = it;
                if (r < I_UP) { tr_up(ap->in[I_F1W1] + wff, ap->in[I_F1W3] + wff, (bf16_t*)(ws + W_UP1), r, scr, lane); continue; } r -= I_UP;
                if (r < I_UP) { tr_up(ap->in[I_F2W1] + wff, ap->in[I_F2W3] + wff, (bf16_t*)(ws + W_UP2), r, scr, lane); continue; } r -= I_UP;
                if (r < I_DN) { tr_plain(ap->in[I_F1W2] + wff, FF, DM, (bf16_t*)(ws + W_DN1), r, scr, lane); continue; } r -= I_DN;
                if (r < I_DN) { tr_plain(ap->in[I_F2W2] + wff, FF, DM, (bf16_t*)(ws + W_DN2), r, scr, lane); continue; } r -= I_DN;
                if (r < n_in) { if (even) tr_plain(ap->in[I_EWIN] + (size_t)jj * DM * EVEN_IN, DM, EVEN_IN, (bf16_t*)(ws + W_IN), r, scr, lane);
                                else tr_plain(ap->in[I_OWIN] + (size_t)jj * DM * ODD_IN, DM, ODD_IN, (bf16_t*)(ws + W_IN), r, scr, lane); continue; } r -= n_in;
                if (r < I_OUT) { tr_plain((even ? ap->in[I_EWOUT] : ap->in[I_OWOUT]) + (size_t)jj * DM * DM, DM, DM, (bf16_t*)(ws + W_OUT), r, scr, lane); continue; } r -= I_OUT;
                if (r < I_QBI) { tr_plain(ap->in[I_WQB] + (size_t)jj * 384 * 768, 384, 768, (bf16_t*)(ws + W_QB), r, scr, lane); continue; } r -= I_QBI;
                if (r < I_KVBI) { tr_plain(ap->in[I_WKVB] + (size_t)jj * 256 * 1024, 256, 1024, (bf16_t*)(ws + W_KVB), r, scr, lane); continue; } r -= I_KVBI;
                { u32x4* z = (u32x4*)((bf16_t*)(ws + W_IN) + (size_t)(ODD_IN + r) * DM); z[lane] = (u32x4){0u, 0u, 0u, 0u}; z[64 + lane] = (u32x4){0u, 0u, 0u, 0u}; }
            }
            if (li == 0) rmsnorm_rows(ap->in[I_X], ap->in[I_F1N], hn, gw, NGW, lane); else rmsnorm_rows_bf16(hbf, ap->in[I_F1N] + li * DM, hn, gw, NGW, lane);
        } else if (st == 1 || st == 10) {
            pg8::Gemm g{hn, (const bf16_t*)(ws + (st == 1 ? W_UP1 : W_UP2)), T, 2 * FF, DM, DM}; pg8::StaticOrder S; S.init(T, 2 * FF, G, bid);
            pg8::EpiSwiglu E{big, FF};
            pg8::gemm_phase<pg8::EpiSwiglu, pg8::StaticOrder>(lds, g, S, E, tid);
        } else if (st == 2 || st == 11) {
            pg8::Gemm g{big, (const bf16_t*)(ws + (st == 2 ? W_DN1 : W_DN2)), T, DM, FF, FF}; pg8::StaticOrder S; S.init(T, DM, G, bid);
            pg8::EpiResid E{(li == 0 && st == 2) ? ap->in[I_X] : (const float*)nullptr, hbf, DM, 0.5f};
            pg8::gemm_phase<pg8::EpiResid, pg8::StaticOrder>(lds, g, S, E, tid);
        } else if (st == 3 || st == 9) {
            rmsnorm_rows_bf16(hbf, (st == 3 ? ap->in[I_MIXN] : ap->in[I_F2N]) + li * DM, hn, gw, NGW, lane);
        } else if (st == 4) {
            const int N = even ? EVEN_IN : ODD_INP;
            pg8::Gemm g{hn, (const bf16_t*)(ws + W_IN), T, N, DM, DM}; pg8::StaticOrder S; S.init(T, N, G, bid);
            pg8::EpiBf16 E{big, N};
            pg8::gemm_phase<pg8::EpiBf16, pg8::StaticOrder>(lds, g, S, E, tid);
        } else if (st == 5) {
            if (even) {
                for (int row = gw; row < T; row += NGW) {
                    const int pos = row & (SEQ - 1); bf16_t* p = big + (size_t)row * EVEN_IN + (lane >> 2) * 64 + (lane & 3) * 8;
                    const u32x4 va = *(const u32x4*)(big + (size_t)row * EVEN_IN + 1024 + lane * 8);
                    u32x4 a = *(const u32x4*)p, b = *(const u32x4*)(p + 32);
                    rope8(a, b, cosT + pos * 32 + (lane & 3) * 8, sinT + pos * 32 + (lane & 3) * 8, 1);
                    bf16_t* kcr = hn + ((size_t)(row - pos) + ((pos & 15) << 8) + (pos >> 4)) * 1024;
                    if (lane < 32) { *(u32x4*)p = a; *(u32x4*)(p + 32) = b; }
                    else { bf16_t* kq = kcr + ((lane >> 2) - 8) * 64 + (lane & 3) * 8; *(u32x4*)kq = a; *(u32x4*)(kq + 32) = b; }
                    *(u32x4*)(kcr + 512 + lane * 8) = va;
                }
            } else {
                const float* qn = ap->in[I_QN] + jj * 384; const float* kvn = ap->in[I_KVN] + jj * 256;
                for (int row = gw; row < T; row += NGW) {
                    const int pos = row & (SEQ - 1); bf16_t* pr = big + (size_t)row * ODD_INP;
                    if (lane < 40) {
                        bf16_t* p = pr + (lane >> 2) * 64 + (lane & 3) * 8;
                        u32x4 a = *(const u32x4*)p, b = *(const u32x4*)(p + 32);
                        rope8(a, b, cosT + pos * 32 + (lane & 3) * 8, sinT + pos * 32 + (lane & 3) * 8, 1);
                        *(u32x4*)p = a; *(u32x4*)(p + 32) = b;
                    } else if (lane < 42) {
                        bf16_t* p = pr + 1408 + (lane - 40) * 8;
                        u32x4 a = *(const u32x4*)p, b = *(const u32x4*)(p + 16);
                        rope8(a, b, cosT + pos * 32 + (lane - 40) * 16, sinT + pos * 32 + (lane - 40) * 16, 2);
                        *(u32x4*)p = a; *(u32x4*)(p + 16) = b;
                    }
                    u32x4 qa = (u32x4){0u, 0u, 0u, 0u}, ka = (u32x4){0u, 0u, 0u, 0u};
                    if (lane < 48) qa = *(const u32x4*)(pr + 768 + lane * 8);
                    if (lane < 32) ka = *(const u32x4*)(pr + 1152 + lane * 8);
                    float sq = 0.f, sk = 0.f;
#pragma unroll
                    for (int j = 0; j < 4; ++j) { const float a0 = bf_lo(qa[j]), a1 = bf_hi(qa[j]), b0 = bf_lo(ka[j]), b1 = bf_hi(ka[j]); sq += a0 * a0 + a1 * a1; sk += b0 * b0 + b1 * b1; }
                    const float rq = 1.0f / sqrtf(wave_sum(sq) * (1.0f / 384.0f) + NORM_EPS), rk = 1.0f / sqrtf(wave_sum(sk) * (1.0f / 256.0f) + NORM_EPS);
                    if (lane < 48) { u32x4 w;
#pragma unroll
                        for (int j = 0; j < 4; ++j) w[j] = cvt_pk_bf16(bf_lo(qa[j]) * rq * qn[lane * 8 + 2 * j], bf_hi(qa[j]) * rq * qn[lane * 8 + 2 * j + 1]);
                        *(u32x4*)(pr + 768 + lane * 8) = w; }
                    if (lane < 32) { u32x4 w;
#pragma unroll
                        for (int j = 0; j < 4; ++j) w[j] = cvt_pk_bf16(bf_lo(ka[j]) * rk * kvn[lane * 8 + 2 * j], bf_hi(ka[j]) * rk * kvn[lane * 8 + 2 * j + 1]);
                        *(u32x4*)(pr + 1152 + lane * 8) = w; }
                }
            }
        } else if (st == 6) {
            if (even) {
                LAS unsigned char* wl = lds + wave * AW_BYTES;
                constexpr int NDIL = 3 * 8192, NNA = 8192;
                const float* rpb = ap->in[I_RPB] + (size_t)jj * 8 * 465;
                const int vcu = (G % 8 == 0) ? (bid % 8) * (G / 8) + bid / 8 : bid;
                const int h = wave;
                { constexpr int DK_KSTR = 144, DK_VHS = 416 * 64, DK_V = 416 * DK_KSTR, DK_WSF = DK_V + 2 * DK_VHS, DK_STG = DK_WSF + NWAVES * 256;
                  static_assert(DK_STG + NWAVES * 4096 <= LDS_BYTES - 64, "dilated LDS");
                  const int WPW = (3072 + G - 1) / G, w1 = (vcu + 1) * WPW < 3072 ? (vcu + 1) * WPW : 3072;
                  const int r32 = lane & 31, hi = lane >> 5;
                  { unsigned zz = 0u; asm volatile("" : "+v"(zz)); const u32x4 z4 = (u32x4){zz, zz, zz, zz};
                    if (tid < 288) *(LAS u32x4*)(lds + 384 * DK_KSTR + tid * 16) = z4;
                    if (tid < 256) *(LAS u32x4*)(lds + DK_V + (tid >> 7) * DK_VHS + 384 * 64 + (tid & 127) * 16) = z4; }
                  for (int wi = vcu * WPW; wi < w1; ++wi) {
                    const int hh_ = wi & 7, x16 = (wi >> 3) & 15, b = (wi >> 7) & 7, c = wi >> 10;
                    const int d = (c == 0) ? 1 : (c == 1) ? 4 : 16, nb = 16 / d, r = x16 / nb, ib = x16 % nb, sd = SEQ / d;
                    const int kb0 = 256 * ib - 64;
                    u32x4 ka[3], kb_[3], vreg[6];
                    const bf16_t* pb = big + (size_t)(b * SEQ) * EVEN_IN + hh_ * 64;
#pragma unroll
                    for (int j = 0; j < 3; ++j) { const int idx = tid + 512 * j, row = idx >> 2, c4 = idx & 3; const int tk = clampi(kb0 + row, 0, sd - 1) * d + r;
                        const bf16_t* gp = pb + (size_t)tk * EVEN_IN + 512 + c4 * 8; ka[j] = *(const u32x4*)gp; kb_[j] = *(const u32x4*)(gp + 32); }
#pragma unroll
                    for (int j = 0; j < 6; ++j) { const int idx = tid + 512 * j, row = idx >> 3, cc = idx & 7; const int tk = clampi(kb0 + row, 0, sd - 1) * d + r;
                        vreg[j] = *(const u32x4*)(pb + (size_t)tk * EVEN_IN + 1024 + cc * 8); }
                    const int ci0 = 256 * ib + 32 * wave;
                    DilSpec sp{big, hn, oc + (size_t)c * T * 512, lse + (size_t)c * T * 8, b, r, d, sd, ci0, hh_, ci0 - 64};
                    bf16x8 q[4];
                    { const bf16_t* qp = sp.qrow(r32);
#pragma unroll
                      for (int d0 = 0; d0 < 4; ++d0) q[d0] = *(const bf16x8*)(qp + d0 * 16 + hi * 8); }
                    __syncthreads();
#pragma unroll
                    for (int j = 0; j < 3; ++j) { const int idx = tid + 512 * j, row = idx >> 2, c4 = idx & 3; const int tk = clampi(kb0 + row, 0, sd - 1) * d + r;
                        rope8_fly(ka[j], kb_[j], (float)tk, c4 * 8);
                        *(LAS u32x4*)(lds + row * DK_KSTR + c4 * 16) = ka[j]; *(LAS u32x4*)(lds + row * DK_KSTR + (c4 + 4) * 16) = kb_[j]; }
#pragma unroll
                    for (int j = 0; j < 6; ++j) { const int idx = tid + 512 * j, row = idx >> 3, cc = idx & 7;
                        *(LAS u32x4*)(lds + DK_V + (cc >> 2) * DK_VHS + row * 64 + (cc & 3) * 16) = vreg[j]; }
                    { const float qpos = (float)((ci0 + r32) * d + r);
                      u32x4 a0 = __builtin_bit_cast(u32x4, q[0]), b0 = __builtin_bit_cast(u32x4, q[2]), a1 = __builtin_bit_cast(u32x4, q[1]), b1 = __builtin_bit_cast(u32x4, q[3]);
                      rope8_fly(a0, b0, qpos, 8 * hi); rope8_fly(a1, b1, qpos, 16 + 8 * hi);
                      q[0] = __builtin_bit_cast(bf16x8, a0); q[2] = __builtin_bit_cast(bf16x8, b0); q[1] = __builtin_bit_cast(bf16x8, a1); q[3] = __builtin_bit_cast(bf16x8, b1); }
                    f32x16 o[2];
#pragma unroll
                    for (int rr = 0; rr < 16; ++rr) { o[0][rr] = 0.f; o[1][rr] = 0.f; }
                    float m = -INFINITY, l = 0.f;
                    LAS float* wsf = (LAS float*)(lds + DK_WSF + wave * 256);
                    __syncthreads();
                    for (int t = 0; t < 3; ++t) {
                        if (sp.skip(t)) continue;
                        const int ro = 32 * wave + 64 * t;
                        u32x4 pw[4];
                        attn_scores<4, DilSpec>(q, lds + ro * DK_KSTR, DK_KSTR, o, m, l, sp, t, wsf, lane, pw);
                        attn_pv(pw, lds + DK_V + ro * 64, o, lane, DK_VHS);
                    }
                    const float lt = attn_finish(o, l, sp, wsf, (LAS bf16_t*)(lds + DK_STG + wave * 4096), lane);
                    sp.finish(m, lt, r32, hi);
                  }
                  __syncthreads(); }
                { constexpr int NK_ROWS = 120, NK_KSTR = 144, NK_VHS = NK_ROWS * 64, NK_KB = NK_ROWS * NK_KSTR, NK_BUF = NK_KB + 2 * NK_VHS, NK_WSF = 2 * NK_BUF, NK_BIAS = NK_WSF + NWAVES * 256, NK_STG = NK_BIAS + 2048;
                  static_assert(NK_STG + NWAVES * 4096 <= LDS_BYTES - 64, "neighbourhood LDS");
                  const int WPW = (1024 + G - 1) / G, w1 = (vcu + 1) * WPW < 1024 ? (vcu + 1) * WPW : 1024;
                  const int r32 = lane & 31, hi = lane >> 5;
                  for (int wi = vcu * WPW; wi < w1; ++wi) {
                    const int hh_ = wi & 7, g8 = (wi >> 3) & 7, hf = (wi >> 6) & 1, b = wi >> 7;
                    const int gr = 8 * g8 + wave, rsw = clampi(gr - 4, 0, 56), rmin = clampi(8 * g8 - 4, 0, 56), rmax = clampi(8 * g8 + 3, 0, 56) + 7, nch = (rmax - rmin + 1) * 64;
                    const int cb = hf ? 24 : 0;
                    const bf16_t* kvb = big + (size_t)(b * SEQ) * EVEN_IN + hh_ * 64;
                    u32x4 kreg[2], vreg[2];
#define NK_LOAD(tt) do { _Pragma("unroll") for (int j = 0; j < 2; ++j) { const int idx = tid + 512 * j; if (idx < nch) { const int row = idx >> 3, cc = idx & 7; \
                        const bf16_t* gp = kvb + (size_t)((rmin + (row >> 3)) * 64 + cb + 8 * (tt) + (row & 7)) * EVEN_IN + cc * 8; kreg[j] = *(const u32x4*)(gp + 2048); vreg[j] = *(const u32x4*)(gp + 2560); } } } while (0)
#define NK_STORE(bf) do { _Pragma("unroll") for (int j = 0; j < 2; ++j) { const int idx = tid + 512 * j; if (idx < nch) { const int row = idx >> 3, cc = idx & 7; \
                        *(LAS u32x4*)(lds + (bf) * NK_BUF + row * NK_KSTR + cc * 16) = kreg[j]; *(LAS u32x4*)(lds + (bf) * NK_BUF + NK_KB + (cc >> 2) * NK_VHS + row * 64 + (cc & 3) * 16) = vreg[j]; } } } while (0)
                    NK_LOAD(0);
                    LAS float* bt = (LAS float*)(lds + NK_BIAS);
                    NaSpec sp{big, mixed, bt, b, gr, hf, hh_, rsw, cb};
                    bf16x8 q[4];
                    { const bf16_t* qp = sp.qrow(r32);
#pragma unroll
                      for (int d0 = 0; d0 < 4; ++d0) q[d0] = *(const bf16x8*)(qp + d0 * 16 + hi * 8); }
                    const float bv = (tid < 465) ? 8.0f * rpb[hh_ * 465 + tid] : 0.f;
                    __syncthreads();
                    NK_STORE(0); if (tid < 465) bt[tid] = bv;
                    NK_LOAD(1);
                    f32x16 o[2];
#pragma unroll
                    for (int rr = 0; rr < 16; ++rr) { o[0][rr] = 0.f; o[1][rr] = 0.f; }
                    float m = -INFINITY, l = 0.f;
                    LAS float* wsf = (LAS float*)(lds + NK_WSF + wave * 256);
                    const int ro = (rsw - rmin) * 8;
                    __syncthreads();
                    for (int t = 0; t < 5; ++t) {
                        const int cur = t & 1;
                        if (t + 1 < 5) NK_STORE(cur ^ 1);
                        if (t + 2 < 5) NK_LOAD(t + 2);
                        u32x4 pw[4];
                        attn_scores<4, NaSpec>(q, lds + cur * NK_BUF + ro * NK_KSTR, NK_KSTR, o, m, l, sp, t, wsf, lane, pw);
                        attn_pv(pw, lds + cur * NK_BUF + NK_KB + ro * 64, o, lane, NK_VHS);
                        __syncthreads();
                    }
                    attn_finish(o, l, sp, wsf, (LAS bf16_t*)(lds + NK_STG + wave * 4096), lane);
#undef NK_LOAD
#undef NK_STORE
                  }
                  __syncthreads(); }
            } else {
                { pg8::Gemm g{big + 768, (const bf16_t*)(ws + W_QB), T, 768, 384, ODD_INP}; pg8::StaticOrder S; S.init(T, 768, G, bid);
                  pg8::EpiBf16 E{qmla, 768}; pg8::gemm_phase<pg8::EpiBf16, pg8::StaticOrder>(lds, g, S, E, tid); }
                { pg8::Gemm g{big + 1152, (const bf16_t*)(ws + W_KVB), T, 1024, 256, ODD_INP}; pg8::StaticOrder S; S.init(T, 1024, G, bid);
                  pg8::EpiBf16 E{kvmla, 1024}; pg8::gemm_phase<pg8::EpiBf16, pg8::StaticOrder>(lds, g, S, E, tid); }
            }
        } else if (st == 7) {
            if (even) {
                for (int row = gw; row < T; row += NGW) {
                    const int h = lane >> 3;
                    const float l0 = lse[(size_t)row * 8 + h], l1 = lse[(size_t)T * 8 + (size_t)row * 8 + h], l2 = lse[(size_t)2 * T * 8 + (size_t)row * 8 + h];
                    const float mx = fmaxf(l0, fmaxf(l1, l2)); float w0 = __expf(l0 - mx), w1 = __expf(l1 - mx), w2 = __expf(l2 - mx); const float inv = 1.0f / (w0 + w1 + w2); w0 *= inv; w1 *= inv; w2 *= inv;
                    const u32x4 a = *(const u32x4*)(oc + (size_t)row * 512 + lane * 8), b = *(const u32x4*)(oc + (size_t)T * 512 + (size_t)row * 512 + lane * 8), c = *(const u32x4*)(oc + (size_t)2 * T * 512 + (size_t)row * 512 + lane * 8);
                    u32x4 w;
#pragma unroll
                    for (int j = 0; j < 4; ++j) w[j] = cvt_pk_bf16(w0 * bf_lo(a[j]) + w1 * bf_lo(b[j]) + w2 * bf_lo(c[j]), w0 * bf_hi(a[j]) + w1 * bf_hi(b[j]) + w2 * bf_hi(c[j]));
                    *(u32x4*)(mixed + (size_t)row * DM + lane * 8) = w;
                }
            } else {

#if EN_MLA
                for (int u = bid; u < 1024; u += G) {
                    const int h = u & 7, qb = (u >> 3) & 15, b = u >> 7;
                    const int r32 = lane & 31, hi = lane >> 5;
                    const int tok0 = b * SEQ + 256 * qb + 32 * wave;
                    bf16x8 q[6];
                    { const bf16_t* qp = qmla + (size_t)(tok0 + r32) * 768 + h * 96;
#pragma unroll
                      for (int d0 = 0; d0 < 6; ++d0) q[d0] = *(const bf16x8*)(qp + d0 * 16 + hi * 8);
                      const int pos = (tok0 + r32) & (SEQ - 1);
                      u32x4 a = __builtin_bit_cast(u32x4, q[4]), bb = __builtin_bit_cast(u32x4, q[5]);
                      rope8(a, bb, cosT + pos * 32 + hi * 16, sinT + pos * 32 + hi * 16, 2);
                      q[4] = __builtin_bit_cast(bf16x8, a); q[5] = __builtin_bit_cast(bf16x8, bb); }
                    f32x16 o[2];
#pragma unroll
                    for (int r = 0; r < 16; ++r) { o[0][r] = 0.f; o[1][r] = 0.f; }
                    float m = -INFINITY, l = 0.f;
                    MlaSpec sp{mixed, tok0, h};
                    LAS float* wsf = (LAS float*)(lds + ML_WSF + wave * 256);
                    const int krow = tid >> 3, kc = tid & 7, prow = (tid & 255) >> 2, pc = tid & 3;
                    const bf16_t* kvp = kvmla + (size_t)(b * SEQ + krow) * 1024 + h * 128 + kc * 8;
                    const bf16_t* pep = big + (size_t)(b * SEQ + prow) * ODD_INP + 1408 + pc * 8;
                    u32x4 kn, vv, pe = (u32x4){0u, 0u, 0u, 0u};
#define MLA_LOAD(tt) do { kn = *(const u32x4*)(kvp + (size_t)(tt) * 64 * 1024); vv = *(const u32x4*)(kvp + (size_t)(tt) * 64 * 1024 + 64); if (tid < 256) pe = *(const u32x4*)(pep + (size_t)(tt) * 64 * ODD_INP); } while (0)
#define MLA_STORE(slot) do { *(LAS u32x4*)(lds + ML_K0 + (slot) * ML_KB + krow * ML_KSTRIDE + kc * 16) = kn; *(LAS u32x4*)(lds + ML_V0 + (slot) * ML_VB + (kc >> 2) * 4096 + krow * 64 + (kc & 3) * 16) = vv; \
                        if (tid < 256) *(LAS u32x4*)(lds + ML_K0 + (slot) * ML_KB + prow * ML_KSTRIDE + 128 + pc * 16) = pe; } while (0)
                    MLA_LOAD(0);
                    __syncthreads();
                    MLA_STORE(0); MLA_LOAD(1); MLA_STORE(1); MLA_LOAD(2);
                    __syncthreads();
                    f32x16 pA0, pA1, pB0, pB1;
                    { const LAS unsigned char* kp = lds + ML_K0 + r32 * ML_KSTRIDE + hi * 16;
#pragma unroll
                      for (int r = 0; r < 16; ++r) { pA0[r] = 0.f; pA1[r] = 0.f; pB0[r] = 0.f; pB1[r] = 0.f; }
#pragma unroll
                      for (int d0 = 0; d0 < 6; ++d0) { pA0 = MFMA32(*(const LAS bf16x8*)(kp + d0 * 32), q[d0], pA0); pA1 = MFMA32(*(const LAS bf16x8*)(kp + 32 * ML_KSTRIDE + d0 * 32), q[d0], pA1); } }
                    int s0 = 0, s1 = 1, s2 = 2;
#define MLA_ROT() do { const int s_ = s0; s0 = s1; s1 = s2; s2 = s_; } while (0)
                    for (int t = 0; t < 62; t += 2) {
                        MLA_STORE(s2); if (t + 3 < 64) MLA_LOAD(t + 3);
                        dense_step<6, true>(q, lds + ML_K0 + s1 * ML_KB, ML_KSTRIDE, lds + ML_V0 + s0 * ML_VB, pA0, pA1, pB0, pB1, o, m, l, MlaSpec::SC, wsf, lane);
                        __syncthreads(); MLA_ROT();
                        if (t + 3 < 64) { MLA_STORE(s2); } if (t + 4 < 64) MLA_LOAD(t + 4);
                        dense_step<6, true>(q, lds + ML_K0 + s1 * ML_KB, ML_KSTRIDE, lds + ML_V0 + s0 * ML_VB, pB0, pB1, pA0, pA1, o, m, l, MlaSpec::SC, wsf, lane);
                        __syncthreads(); MLA_ROT();
                    }
                    dense_step<6, true>(q, lds + ML_K0 + s1 * ML_KB, ML_KSTRIDE, lds + ML_V0 + s0 * ML_VB, pA0, pA1, pB0, pB1, o, m, l, MlaSpec::SC, wsf, lane);
                    __syncthreads(); MLA_ROT();
                    dense_step<6, false>(q, lds + ML_K0 + s1 * ML_KB, ML_KSTRIDE, lds + ML_V0 + s0 * ML_VB, pB0, pB1, pA0, pA1, o, m, l, MlaSpec::SC, wsf, lane);
#undef MLA_LOAD
#undef MLA_STORE
#undef MLA_ROT
                    attn_finish(o, l, sp, wsf, (LAS bf16_t*)(lds + ML_STG + wave * 4096), lane);
                }

#endif
                __syncthreads();
                LAS unsigned char* wl = lds + wave * AW_BYTES;
                const float* sink = ap->in[I_SINK] + jj * 8;

#if EN_SWA
                { const int vcu = (G % 8 == 0) ? (bid % 8) * (G / 8) + bid / 8 : bid, hq = wave;
                  const int PPW = (1024 + G - 1) / G, p1 = (vcu + 1) * PPW < 1024 ? (vcu + 1) * PPW : 1024;
                  for (int p = vcu * PPW; p < p1; ++p) {
                    const int qc = p & 127, b = p >> 7;
                    SwaSpec sp{big, mixed, b, hq, hq >> 2, 32 * qc, 32 * qc - 128};
                    attn_wave_item(sp, wl, lane, sink[hq] * LOG2E, 1.0f);
                  } }

#endif
            }
        } else if (st == 8) {
            pg8::Gemm g{mixed, (const bf16_t*)(ws + W_OUT), T, DM, DM, DM}; pg8::StaticOrder S; S.init(T, DM, G, bid);
            pg8::EpiResid E{(const float*)nullptr, hbf, DM, 1.0f};
            pg8::gemm_phase<pg8::EpiResid, pg8::StaticOrder>(lds, g, S, E, tid);
        }
#if PROBE_DUP
        { const bool isatt = (ph < DEPTH * 12) && ((even && st == 6) || (!even && st == 7));
          const bool ismisc = (ph < DEPTH * 12) && (st == 0 || st == 3 || st == 9 || (even && st == 7));
          const bool isup = (ph < DEPTH * 12) && (st == 1 || st == 10);
          if (!dup_done && ((PROBE_DUP == 1 && isatt) || (PROBE_DUP == 2 && ismisc) || (PROBE_DUP == 3 && isup))) { dup_done = true; --ph; } else dup_done = false; }
#endif
        if (ph + 1 < args.ph_hi) {
            if (args.ph_hi < 0) { __syncthreads(); grid.sync(); }
            xcd_barrier(xbar);
            if (PROBE_DUP == 4) xcd_barrier(xbar);
        }
    }
}

extern "C" void kernel_launch(void* const* d_in, const int* in_sizes, int n_in, void* d_out, int out_size, void* d_ws, size_t ws_size, hipStream_t stream) {
    static int grid = 0;
    if (grid == 0) {
        if (n_in != 21 || ws_size < WS_END) { fprintf(stderr, "kernel_launch: unexpected inputs (n_in %d, ws %zu < %zu)\n", n_in, ws_size, (size_t)WS_END); grid = -1; return; }
        int dev = 0, cus = 0, per_cu = 0;
        hipGetDevice(&dev); hipDeviceGetAttribute(&cus, hipDeviceAttributeMultiprocessorCount, dev);
        if (hipFuncSetAttribute((const void*)fwd_megakernel, hipFuncAttributeMaxDynamicSharedMemorySize, LDS_BYTES) != hipSuccess) { fprintf(stderr, "kernel_launch: hipFuncSetAttribute failed\n"); grid = -1; return; }
        if (hipOccupancyMaxActiveBlocksPerMultiprocessor(&per_cu, (const void*)fwd_megakernel, NTHREADS, LDS_BYTES) != hipSuccess || per_cu < 1) { fprintf(stderr, "kernel_launch: occupancy query gave %d\n", per_cu); per_cu = 1; }
        (void)hipGetLastError();
        grid = cus * per_cu;
    }
    if (grid < 0) return;
    Args a{};
    for (int i = 0; i < 21; ++i) a.in[i] = (const float*)d_in[i];
    a.out = (float*)d_out; a.ws = (unsigned char*)d_ws;
    a.ph_lo = 0; a.ph_hi = DEPTH * 12 + 1;
    if (hipMemsetAsync((char*)d_ws + WS_BAR, 0, 16384, stream) != hipSuccess) { fprintf(stderr, "kernel_launch: memset failed\n"); return; }
    void* kargs[] = {&a};
    hipError_t e = hipLaunchCooperativeKernel((const void*)fwd_megakernel, dim3(grid), dim3(NTHREADS), kargs, LDS_BYTES, stream);
    if (e != hipSuccess) fprintf(stderr, "cooperative launch failed: %s (grid %d)\n", hipGetErrorString(e), grid);
}
```
